# Optimizing an MI355X kernel written in HIP

```python
import math
import jax, jax.numpy as jnp
from jax import lax
import numpy as np

D_MODEL = 4096
BATCH = 4
SEQ = 4096
DEPTH = 1

HEAD_DIM = 128
N_HEADS_A = 16
N_KV_A = 2
WINDOW = 128
N_HEADS_B = 16
N_KV_B = 4
MOBA_BLOCK = 256
MOBA_TOPK = 3
MOBA_Q_CHUNK = 16
D_FF = 11008
EPS = 1e-6
NEG_INF = -1e30
N_MOD = 9

WIDTH_A = N_HEADS_A * HEAD_DIM
WIDTH_B = N_HEADS_B * HEAD_DIM
KV_A = N_KV_A * HEAD_DIM
KV_B = N_KV_B * HEAD_DIM
D_MIX = WIDTH_A + WIDTH_B
D_IN = WIDTH_A + 2 * KV_A + WIDTH_B + 2 * KV_B

kernel_name = "hybrid_swa_sink_moba_macaron_block"


def rms_norm(x, g):
    xf = x.astype(jnp.float32)
    y = xf * lax.rsqrt(jnp.mean(xf * xf, axis=-1, keepdims=True) + EPS)
    return (y * g.astype(jnp.float32)).astype(x.dtype)


def alibi_slopes(n):
    return 2.0 ** (-8.0 * jnp.arange(1, n + 1, dtype=jnp.float32) / n)


def swiglu(h, w_gate, w_up, w_down):
    return (jax.nn.silu(h @ w_gate) * (h @ w_up)) @ w_down


def sliding_window_attention(q, k, v, sinks, slopes):
    b, s = q.shape[0], q.shape[1]
    nb = s // WINDOW
    g = N_HEADS_A // N_KV_A
    qb = q.reshape(b, nb, WINDOW, N_KV_A, g, HEAD_DIM)
    kb = k.reshape(b, nb, WINDOW, N_KV_A, HEAD_DIM)
    vb = v.reshape(b, nb, WINDOW, N_KV_A, HEAD_DIM)

    def with_prev(t):
        prev = jnp.pad(t, ((0, 0), (1, 0), (0, 0), (0, 0), (0, 0)))[:, :-1]
        return jnp.concatenate([prev, t], axis=2)

    kk, vv = with_prev(kb), with_prev(vb)
    scores = jnp.einsum('bnqhgd,bnkhd->bnhgqk', qb, kk).astype(jnp.float32) * (HEAD_DIM ** -0.5)
    qi = jnp.arange(WINDOW)[:, None] + WINDOW
    kj = jnp.arange(2 * WINDOW)[None, :]
    dist = qi - kj
    valid = (dist >= 0) & (dist < WINDOW)
    valid = valid[None] & ((jnp.arange(nb)[:, None, None] > 0) | (kj[None] >= WINDOW))
    m = slopes.reshape(N_KV_A, g)[:, :, None, None]
    scores = scores - m * dist.astype(jnp.float32)
    scores = jnp.where(valid[None, :, None, None], scores, NEG_INF)
    sink = sinks.astype(jnp.float32).reshape(N_KV_A, g)[:, :, None, None]
    mx = jnp.maximum(scores.max(axis=-1, keepdims=True), sink)
    p = jnp.exp(scores - mx)
    denom = p.sum(axis=-1, keepdims=True) + jnp.exp(sink - mx)
    o = jnp.einsum('bnhgqk,bnkhd->bnqhgd', (p / denom).astype(v.dtype), vv)
    return o.reshape(b, s, WIDTH_A)


def moba_attention(q, k, v, slopes):
    b, s = q.shape[0], q.shape[1]
    g = N_HEADS_B // N_KV_B
    s_pad = -(-s // MOBA_BLOCK) * MOBA_BLOCK
    pad = ((0, 0), (0, s_pad - s), (0, 0), (0, 0))
    q = jnp.pad(q, pad).reshape(b, s_pad, N_KV_B, g, HEAD_DIM)
    k = jnp.pad(k, pad)
    v = jnp.pad(v, pad)
    nblk = s_pad // MOBA_BLOCK
    top_k = min(MOBA_TOPK, nblk)
    kb = k.reshape(b, nblk, MOBA_BLOCK, N_KV_B, HEAD_DIM).transpose(0, 3, 1, 2, 4)
    vb = v.reshape(b, nblk, MOBA_BLOCK, N_KV_B, HEAD_DIM).transpose(0, 3, 1, 2, 4)
    k_mean = kb.astype(jnp.float32).mean(axis=3)
    gate = jnp.einsum('bthgd,bhnd->bthgn', q.astype(jnp.float32), k_mean)
    own = jnp.arange(s_pad) // MOBA_BLOCK
    past = jnp.arange(nblk)[None, :] < own[:, None]
    gate = jnp.where(past[None, :, None, None, :], gate, NEG_INF)
    _, sel = lax.top_k(gate, top_k)
    scale = HEAD_DIM ** -0.5
    m = slopes.reshape(N_KV_B, g)
    b_ix = jnp.arange(b)[:, None, None, None, None]
    h_ix = jnp.arange(N_KV_B)[None, None, :, None, None]
    blk_pos = jnp.arange(MOBA_BLOCK)
    n_chunks = s_pad // MOBA_Q_CHUNK

    def chunk(ci):
        start = ci * MOBA_Q_CHUNK
        qc = lax.dynamic_slice_in_dim(q, start, MOBA_Q_CHUNK, axis=1)
        sc = lax.dynamic_slice_in_dim(sel, start, MOBA_Q_CHUNK, axis=1)
        tq = start + jnp.arange(MOBA_Q_CHUNK)
        own_blk = start // MOBA_BLOCK
        k_sel = kb[b_ix, h_ix, sc]
        v_sel = vb[b_ix, h_ix, sc]
        s_sel = jnp.einsum('bchgd,bchgnkd->bchgnk', qc, k_sel).astype(jnp.float32) * scale
        key_pos = sc[..., None] * MOBA_BLOCK + blk_pos
        dist_sel = (tq[None, :, None, None, None, None] - key_pos).astype(jnp.float32)
        valid_sel = (sc < own_blk)[..., None]
        s_sel = jnp.where(valid_sel, s_sel - m[:, :, None, None] * dist_sel, NEG_INF)
        s_sel = s_sel.reshape(b, MOBA_Q_CHUNK, N_KV_B, g, top_k * MOBA_BLOCK)
        k_own = lax.dynamic_index_in_dim(kb, own_blk, axis=2, keepdims=False)
        v_own = lax.dynamic_index_in_dim(vb, own_blk, axis=2, keepdims=False)
        s_own = jnp.einsum('bchgd,bhkd->bchgk', qc, k_own).astype(jnp.float32) * scale
        dist_own = tq[:, None] - (own_blk * MOBA_BLOCK + blk_pos)[None, :]
        d_own = dist_own[None, :, None, None, :]
        s_own = jnp.where(d_own >= 0, s_own - m[None, None, :, :, None] * d_own.astype(jnp.float32), NEG_INF)
        p = jax.nn.softmax(jnp.concatenate([s_sel, s_own], axis=-1), axis=-1)
        p_sel = p[..., :top_k * MOBA_BLOCK].reshape(b, MOBA_Q_CHUNK, N_KV_B, g, top_k, MOBA_BLOCK).astype(v.dtype)
        p_own = p[..., top_k * MOBA_BLOCK:].astype(v.dtype)
        return (jnp.einsum('bchgnk,bchgnkd->bchgd', p_sel, v_sel)
                + jnp.einsum('bchgk,bhkd->bchgd', p_own, v_own))

    o = lax.map(chunk, jnp.arange(n_chunks))
    o = o.transpose(1, 0, 2, 3, 4, 5).reshape(b, s_pad, WIDTH_B)
    return o[:, :s]


def hybrid_mixer(h, w_in, sinks, norm_a, norm_b, w_out, slopes_a, slopes_b):
    b, s = h.shape[0], h.shape[1]
    proj = h @ w_in
    o0 = 0
    qa = proj[..., o0:o0 + WIDTH_A].reshape(b, s, N_HEADS_A, HEAD_DIM); o0 += WIDTH_A
    ka = proj[..., o0:o0 + KV_A].reshape(b, s, N_KV_A, HEAD_DIM); o0 += KV_A
    va = proj[..., o0:o0 + KV_A].reshape(b, s, N_KV_A, HEAD_DIM); o0 += KV_A
    qb = proj[..., o0:o0 + WIDTH_B].reshape(b, s, N_HEADS_B, HEAD_DIM); o0 += WIDTH_B
    kb = proj[..., o0:o0 + KV_B].reshape(b, s, N_KV_B, HEAD_DIM); o0 += KV_B
    vb = proj[..., o0:o0 + KV_B].reshape(b, s, N_KV_B, HEAD_DIM)
    ya = rms_norm(sliding_window_attention(qa, ka, va, sinks, slopes_a), norm_a)
    yb = rms_norm(moba_attention(qb, kb, vb, slopes_b), norm_b)
    return jnp.concatenate([ya, yb], axis=-1) @ w_out


def setup_inputs(seed: int = 0) -> dict:
    key = jax.random.key(seed)
    ks = jax.random.split(key, 24)
    f32 = jnp.float32

    def nrm(k, shape, scale):
        return jax.random.normal(k, shape, f32) * scale

    def gain(k, n):
        return 1.0 + 0.05 * jax.random.normal(k, (DEPTH, n), f32)

    return {
        "x": nrm(ks[0], (BATCH, SEQ, D_MODEL), 1.0),
        "c": nrm(ks[1], (BATCH, D_MODEL), 1.0),
        "w_ada": nrm(ks[2], (DEPTH, D_MODEL, N_MOD * D_MODEL), D_MODEL ** -0.5),
        "b_ada": nrm(ks[3], (DEPTH, N_MOD * D_MODEL), 0.01),
        "ffn1_norm_pre": gain(ks[4], D_MODEL),
        "ffn1_norm_post": gain(ks[5], D_MODEL),
        "ffn1_w_gate": nrm(ks[6], (DEPTH, D_MODEL, D_FF), D_MODEL ** -0.5),
        "ffn1_w_up": nrm(ks[7], (DEPTH, D_MODEL, D_FF), D_MODEL ** -0.5),
        "ffn1_w_down": nrm(ks[8], (DEPTH, D_FF, D_MODEL), D_FF ** -0.5),
        "mix_norm_pre": gain(ks[9], D_MODEL),
        "mix_norm_post": gain(ks[10], D_MODEL),
        "w_in": nrm(ks[11], (DEPTH, D_MODEL, D_IN), D_MODEL ** -0.5),
        "attn_sinks": nrm(ks[12], (DEPTH, N_HEADS_A), 0.5),
        "norm_a": gain(ks[13], WIDTH_A),
        "norm_b": gain(ks[14], WIDTH_B),
        "w_out": nrm(ks[15], (DEPTH, D_MIX, D_MODEL), D_MIX ** -0.5),
        "ffn2_norm_pre": gain(ks[16], D_MODEL),
        "ffn2_norm_post": gain(ks[17], D_MODEL),
        "ffn2_w_gate": nrm(ks[18], (DEPTH, D_MODEL, D_FF), D_MODEL ** -0.5),
        "ffn2_w_up": nrm(ks[19], (DEPTH, D_MODEL, D_FF), D_MODEL ** -0.5),
        "ffn2_w_down": nrm(ks[20], (DEPTH, D_FF, D_MODEL), D_FF ** -0.5),
    }


def reference(x, c, w_ada, b_ada, ffn1_norm_pre, ffn1_norm_post, ffn1_w_gate, ffn1_w_up, ffn1_w_down,
              mix_norm_pre, mix_norm_post, w_in, attn_sinks, norm_a, norm_b, w_out,
              ffn2_norm_pre, ffn2_norm_post, ffn2_w_gate, ffn2_w_up, ffn2_w_down):
    b = x.shape[0]
    slopes_a = alibi_slopes(N_HEADS_A)
    slopes_b = alibi_slopes(N_HEADS_B)
    for l in range(DEPTH):
        mod = (jax.nn.silu(c) @ w_ada[l] + b_ada[l]).reshape(b, N_MOD, D_MODEL)[:, :, None, :]

        def sublayer(x, fn, i, g_pre, g_post, res_w):
            shift, scale, gate = mod[:, 3 * i], mod[:, 3 * i + 1], mod[:, 3 * i + 2]
            h = rms_norm(x, g_pre) * (1.0 + scale) + shift
            return x + res_w * gate * rms_norm(fn(h), g_post)

        x = sublayer(x, lambda h: swiglu(h, ffn1_w_gate[l], ffn1_w_up[l], ffn1_w_down[l]),
                     0, ffn1_norm_pre[l], ffn1_norm_post[l], 0.5)
        x = sublayer(x, lambda h: hybrid_mixer(h, w_in[l], attn_sinks[l], norm_a[l], norm_b[l], w_out[l],
                                               slopes_a, slopes_b),
                     1, mix_norm_pre[l], mix_norm_post[l], 1.0)
        x = sublayer(x, lambda h: swiglu(h, ffn2_w_gate[l], ffn2_w_up[l], ffn2_w_down[l]),
                     2, ffn2_norm_pre[l], ffn2_norm_post[l], 0.5)
    return x
```

```cpp
#include <hip/hip_runtime.h>
#include <cstdio>
#include <cstdint>
namespace pg8 {
#define PG8_LAS __attribute__((address_space(3)))
typedef unsigned short bf16_t;
typedef short bf16x8 __attribute__((ext_vector_type(8)));
typedef float f32x4 __attribute__((ext_vector_type(4)));
typedef unsigned u32x4 __attribute__((ext_vector_type(4)));
typedef int i32x4 __attribute__((ext_vector_type(4)));
constexpr int BM = 256, BK = 64, HALF = 128, HTB = HALF * BK * 2  , STAGE_BYTES = 8 * HTB, NXCD = 8, WGM = 8;

__host__ __device__ __forceinline__ int lds_byte(int r, int c) { const int st = (r >> 4) * 2 + (c >> 5), rr = r & 15, cc = c & 31, ob = rr * 64 + cc * 2; return st * 1024 + (ob ^ (((ob >> 9) & 1) << 5)); }
__host__ __device__ __forceinline__ void stage_rc(int b, int& R, int& C) { const int st = b / 1024, sb = b % 1024, swz = sb ^ (((sb >> 9) & 1) << 5); R = (st >> 1) * 16 + swz / 64; C = (st & 1) * 32 + (swz % 64) / 2; }
__host__ __device__ __forceinline__ int perm32(int rho) { const int n = rho >> 4, i = rho & 15; return 8 * (i >> 2) + 4 * n + (i & 3); }

struct Unit { int pm, pn; };
struct Gemm { const bf16_t* A; const bf16_t* Bt; int M, N, K; };

struct StaticOrder {
    int nM, nN, nwg, G, c;
    __host__ __device__ void init(int M, int N, int G_, int c_) { nM = M / BM; nN = N / BM; nwg = nM * nN; G = G_; c = c_; }
    __host__ __device__ bool next(int i, Unit& u) const {
        const long L = (long)i * G + c; if (L >= nwg) return false;
        int wgid = (int)L; { const int q = nwg / NXCD, r = nwg % NXCD, xcd = wgid % NXCD, off = wgid / NXCD; wgid = (xcd < r ? xcd * (q + 1) : r * (q + 1) + (xcd - r) * q) + off; }
        const int nig = WGM * nN, gid = wgid / nig, fm = gid * WGM, gsz = (nM - fm) < WGM ? (nM - fm) : WGM;
        u.pm = fm + ((wgid % nig) % gsz); u.pn = (wgid % nig) / gsz; return true;
    }
    __device__ __forceinline__ void a_ready(const Unit&) const {}
    __device__ __forceinline__ void done(const Unit&) const {}
};

__device__ __forceinline__ unsigned cvt_pk_bf16(float lo, float hi) { unsigned r; asm volatile("v_cvt_pk_bf16_f32 %0, %1, %2" : "=v"(r) : "v"(lo), "v"(hi)); return r; }
typedef float f32x2 __attribute__((ext_vector_type(2)));

__device__ __forceinline__ int nth_set(unsigned mask, int n) { for (int i = 0; i < n; ++i) mask &= mask - 1u; return __builtin_ctz(mask); }
struct EpiBf16P {
    static constexpr bool PERM = true, AFTER_DRAIN = false;
    bf16_t* O; int ldc; unsigned tmask;
    __device__ __forceinline__ void operator()(const f32x4 (&acc)[2][2][4][2], const Unit& u, int wr, int wc, int fr, int fq) const {
        const int row0 = u.pm * BM + wr * 64 + fr, col0 = (tmask ? nth_set(tmask, u.pn) : u.pn) * BM + wc * 32 + 8 * fq;
#pragma unroll
        for (int ai = 0; ai < 2; ++ai)
#pragma unroll
            for (int m = 0; m < 4; ++m) { bf16_t* rowp = O + (size_t)(row0 + ai * HALF + m * 16) * ldc + col0;
#pragma unroll
                for (int bj = 0; bj < 2; ++bj) { const f32x4 v0 = acc[ai][bj][m][0], v1 = acc[ai][bj][m][1];
                    u32x4 w; w.x = cvt_pk_bf16(v0[0], v0[1]); w.y = cvt_pk_bf16(v0[2], v0[3]); w.z = cvt_pk_bf16(v1[0], v1[1]); w.w = cvt_pk_bf16(v1[2], v1[3]);
                    *(u32x4*)(rowp + bj * HALF) = w; } }
    }
};
__device__ __forceinline__ float silu_mul(float g, float u) { const float e = __builtin_amdgcn_exp2f(g * -1.4426950408889634f); return g * __builtin_amdgcn_rcpf(1.0f + e) * u; }
struct EpiSwiGLU {
    static constexpr bool PERM = true, AFTER_DRAIN = false;
    bf16_t* O; int ldc;
    __device__ __forceinline__ void operator()(const f32x4 (&acc)[2][2][4][2], const Unit& u, int wr, int wc, int fr, int fq) const {
        const int row0 = u.pm * BM + wr * 64 + fr, col0 = u.pn * HALF + wc * 32 + 8 * fq;
#pragma unroll
        for (int ai = 0; ai < 2; ++ai)
#pragma unroll
            for (int m = 0; m < 4; ++m) { bf16_t* rowp = O + (size_t)(row0 + ai * HALF + m * 16) * ldc + col0;
                const f32x4 g0 = acc[ai][0][m][0], g1 = acc[ai][0][m][1], u0 = acc[ai][1][m][0], u1 = acc[ai][1][m][1];
                u32x4 w; w.x = cvt_pk_bf16(silu_mul(g0[0], u0[0]), silu_mul(g0[1], u0[1])); w.y = cvt_pk_bf16(silu_mul(g0[2], u0[2]), silu_mul(g0[3], u0[3]));
                w.z = cvt_pk_bf16(silu_mul(g1[0], u1[0]), silu_mul(g1[1], u1[1])); w.w = cvt_pk_bf16(silu_mul(g1[2], u1[2]), silu_mul(g1[3], u1[3]));
                *(u32x4*)rowp = w; }
    }
};

__device__ __forceinline__ f32x4 i2f4(const f32x4& a) { const i32x4 i = __builtin_bit_cast(i32x4, a); return (f32x4){(float)i[0], (float)i[1], (float)i[2], (float)i[3]}; }
struct EpiBf16I8 {
    static constexpr bool PERM = true, AFTER_DRAIN = false;
    bf16_t* O; int ldc; const float* sA; const unsigned* cmax; unsigned tmask;
    __device__ __forceinline__ void operator()(const f32x4 (&acc)[2][2][4][2], const Unit& u, int wr, int wc, int fr, int fq) const {
        const int row0 = u.pm * BM + wr * 64 + fr, col0 = u.pn * BM + wc * 32 + 8 * fq, ocol0 = col0 + (nth_set(tmask, u.pn) - u.pn) * BM;
        u32x4 craw[2][2]; float sav[2][4];
#pragma unroll
        for (int bj = 0; bj < 2; ++bj)
#pragma unroll
            for (int n = 0; n < 2; ++n) craw[bj][n] = *(const u32x4*)(cmax + col0 + bj * HALF + 4 * n);
#pragma unroll
        for (int ai = 0; ai < 2; ++ai)
#pragma unroll
            for (int m = 0; m < 4; ++m) sav[ai][m] = sA[row0 + ai * HALF + m * 16];
        asm volatile("" : "+v"(craw[0][0]), "+v"(craw[0][1]), "+v"(craw[1][0]), "+v"(craw[1][1]), "+v"(sav[0][0]), "+v"(sav[0][1]), "+v"(sav[0][2]), "+v"(sav[0][3]), "+v"(sav[1][0]), "+v"(sav[1][1]), "+v"(sav[1][2]), "+v"(sav[1][3]));
        f32x4 sb[2][2];
#pragma unroll
        for (int bj = 0; bj < 2; ++bj)
#pragma unroll
            for (int n = 0; n < 2; ++n) { const u32x4 c = craw[bj][n];
                sb[bj][n] = (f32x4){__uint_as_float(c[0]), __uint_as_float(c[1]), __uint_as_float(c[2]), __uint_as_float(c[3])} * (1.0f / 127.0f); }
#pragma unroll
        for (int ai = 0; ai < 2; ++ai)
#pragma unroll
            for (int m = 0; m < 4; ++m) { const int r = row0 + ai * HALF + m * 16; const float sa = sav[ai][m]; bf16_t* rowp = O + (size_t)r * ldc + ocol0;
#pragma unroll
                for (int bj = 0; bj < 2; ++bj) { const f32x4 v0 = i2f4(acc[ai][bj][m][0]) * (sb[bj][0] * sa), v1 = i2f4(acc[ai][bj][m][1]) * (sb[bj][1] * sa);
                    u32x4 w; w.x = cvt_pk_bf16(v0[0], v0[1]); w.y = cvt_pk_bf16(v0[2], v0[3]); w.z = cvt_pk_bf16(v1[0], v1[1]); w.w = cvt_pk_bf16(v1[2], v1[3]);
                    *(u32x4*)(rowp + bj * HALF) = w; } }
    }
};

struct EpiQ8Y {
    static constexpr bool PERM = true, AFTER_DRAIN = false;
    unsigned char* Q; int ldc; float* ysc; const float* sA; const unsigned* cmax;
    __device__ __forceinline__ void operator()(const f32x4 (&acc)[2][2][4][2], const Unit& u, int wr, int wc, int fr, int fq) const {
        const int row0 = u.pm * BM + wr * 64 + fr, col0 = u.pn * BM + wc * 32 + 8 * fq;
        u32x4 craw[2][2]; float sav[2][4];
#pragma unroll
        for (int bj = 0; bj < 2; ++bj)
#pragma unroll
            for (int n = 0; n < 2; ++n) craw[bj][n] = *(const u32x4*)(cmax + col0 + bj * HALF + 4 * n);
#pragma unroll
        for (int ai = 0; ai < 2; ++ai)
#pragma unroll
            for (int m = 0; m < 4; ++m) sav[ai][m] = sA[row0 + ai * HALF + m * 16];
        asm volatile("" : "+v"(craw[0][0]), "+v"(craw[0][1]), "+v"(craw[1][0]), "+v"(craw[1][1]), "+v"(sav[0][0]), "+v"(sav[0][1]), "+v"(sav[0][2]), "+v"(sav[0][3]), "+v"(sav[1][0]), "+v"(sav[1][1]), "+v"(sav[1][2]), "+v"(sav[1][3]));
        f32x4 sb[2][2];
#pragma unroll
        for (int bj = 0; bj < 2; ++bj)
#pragma unroll
            for (int n = 0; n < 2; ++n) { const u32x4 c = craw[bj][n];
                sb[bj][n] = (f32x4){__uint_as_float(c[0]), __uint_as_float(c[1]), __uint_as_float(c[2]), __uint_as_float(c[3])} * (1.0f / 127.0f); }
        const int ng = ldc >> 5;
#pragma unroll
        for (int ai = 0; ai < 2; ++ai)
#pragma unroll
            for (int m = 0; m < 4; ++m) { const int r = row0 + ai * HALF + m * 16; const float sa = sav[ai][m];
#pragma unroll
                for (int bj = 0; bj < 2; ++bj) { const f32x4 v0 = i2f4(acc[ai][bj][m][0]) * (sb[bj][0] * sa), v1 = i2f4(acc[ai][bj][m][1]) * (sb[bj][1] * sa);
                    float mx = fmaxf(fmaxf(fmaxf(fabsf(v0[0]), fabsf(v0[1])), fmaxf(fabsf(v0[2]), fabsf(v0[3]))), fmaxf(fmaxf(fabsf(v1[0]), fabsf(v1[1])), fmaxf(fabsf(v1[2]), fabsf(v1[3]))));
                    { auto r_ = __builtin_amdgcn_permlane16_swap(__float_as_uint(mx), __float_as_uint(mx), false, false); mx = fmaxf(__uint_as_float(r_[0]), __uint_as_float(r_[1])); }
                    { auto r_ = __builtin_amdgcn_permlane32_swap(__float_as_uint(mx), __float_as_uint(mx), false, false); mx = fmaxf(__uint_as_float(r_[0]), __uint_as_float(r_[1])); }
                    const float inv = mx > 0.f ? 127.0f * __builtin_amdgcn_rcpf(mx) : 0.f;
                    const f32x4 y0 = v0 * inv + (12582912.0f + 128.0f), y1 = v1 * inv + (12582912.0f + 128.0f);
                    typedef unsigned u32x2 __attribute__((ext_vector_type(2)));
                    u32x2 w; w.x = __builtin_amdgcn_perm(__builtin_amdgcn_perm(__float_as_uint(y0[3]), __float_as_uint(y0[2]), 0x0c0c0400u), __builtin_amdgcn_perm(__float_as_uint(y0[1]), __float_as_uint(y0[0]), 0x0c0c0400u), 0x05040100u);
                    w.y = __builtin_amdgcn_perm(__builtin_amdgcn_perm(__float_as_uint(y1[3]), __float_as_uint(y1[2]), 0x0c0c0400u), __builtin_amdgcn_perm(__float_as_uint(y1[1]), __float_as_uint(y1[0]), 0x0c0c0400u), 0x05040100u);
                    const int c = col0 + bj * HALF;
                    *(u32x2*)(Q + (size_t)r * ldc + c) = w;
                    if (fq == 0) ysc[(size_t)r * ng + (c >> 5)] = mx * (1.0f / 127.0f); } }
    }
};
template <bool NOLD = false, bool NORM = false> struct EpiSwiGLUI8T {
    static constexpr bool PERM = true, AFTER_DRAIN = false;
    bf16_t* O; int ldc; const float* sA; const unsigned* cmax; unsigned* rowmax;
    __device__ __forceinline__ void operator()(const f32x4 (&acc)[2][2][4][2], const Unit& u, int wr, int wc, int fr, int fq) const {
        const int row0 = u.pm * BM + wr * 64 + fr, col0 = u.pn * HALF + wc * 32 + 8 * fq, bcol0 = u.pn * BM + wc * 32 + 8 * fq;
        f32x4 sb[2][2];
#pragma unroll
        for (int bj = 0; bj < 2; ++bj)
#pragma unroll
            for (int n = 0; n < 2; ++n) { u32x4 c = (u32x4){0x3f800000u, 0x3f900000u, 0x3fa00000u, 0x3fb00000u}; if (!NOLD) c = *(const u32x4*)(cmax + bcol0 + bj * HALF + 4 * n);
                sb[bj][n] = (f32x4){__uint_as_float(c[0]), __uint_as_float(c[1]), __uint_as_float(c[2]), __uint_as_float(c[3])} * (1.0f / 127.0f); }
#pragma unroll
        for (int ai = 0; ai < 2; ++ai)
#pragma unroll
            for (int m = 0; m < 4; ++m) { const int r = row0 + ai * HALF + m * 16; const float sa = NOLD ? 0.01f : sA[r]; bf16_t* rowp = O + (size_t)r * ldc + col0;
                const f32x4 g0 = i2f4(acc[ai][0][m][0]) * (sb[0][0] * sa), g1 = i2f4(acc[ai][0][m][1]) * (sb[0][1] * sa);
                const f32x4 u0 = i2f4(acc[ai][1][m][0]) * (sb[1][0] * sa), u1 = i2f4(acc[ai][1][m][1]) * (sb[1][1] * sa);
                float v[8];
#pragma unroll
                for (int e = 0; e < 4; ++e) { v[e] = silu_mul(g0[e], u0[e]); v[4 + e] = silu_mul(g1[e], u1[e]); }
                u32x4 w; w.x = cvt_pk_bf16(v[0], v[1]); w.y = cvt_pk_bf16(v[2], v[3]); w.z = cvt_pk_bf16(v[4], v[5]); w.w = cvt_pk_bf16(v[6], v[7]);
                *(u32x4*)rowp = w;
                if (!NORM) { float mx = 0.f;
#pragma unroll
                for (int e = 0; e < 8; ++e) mx = fmaxf(mx, fabsf(v[e]));
                mx = fmaxf(mx, __shfl_xor(mx, 16)); mx = fmaxf(mx, __shfl_xor(mx, 32));
                if (fq == 0) atomicMax(rowmax + r, __float_as_uint(mx)); } }
    }
};

typedef EpiSwiGLUI8T<false, false> EpiSwiGLUI8;

__device__ __forceinline__ f32x2 silu_mul_pk(f32x2 g, f32x2 u) {
    const f32x2 t = g * -1.4426950408889634f;
    f32x2 e; e.x = __builtin_amdgcn_exp2f(t.x); e.y = __builtin_amdgcn_exp2f(t.y);
    const f32x2 d = e + 1.0f;
    f32x2 r; r.x = __builtin_amdgcn_rcpf(d.x); r.y = __builtin_amdgcn_rcpf(d.y);
    return (g * u) * r;
}
struct EpiSwiGLUQ {
    static constexpr bool PERM = true, AFTER_DRAIN = false;
    signed char* Q; int ldc; float* lsc; int nls; const float* sA; const unsigned* cmax; unsigned* rowmax;
    __device__ __forceinline__ void operator()(const f32x4 (&acc)[2][2][4][2], const Unit& u, int wr, int wc, int fr, int fq) const {
        const int row0 = u.pm * BM + wr * 64 + fr, col0 = u.pn * HALF + wc * 32 + 8 * fq, bcol0 = u.pn * BM + wc * 32 + 8 * fq;
        u32x4 craw[2][2]; float sav[2][4];
#pragma unroll
        for (int bj = 0; bj < 2; ++bj)
#pragma unroll
            for (int n = 0; n < 2; ++n) craw[bj][n] = *(const u32x4*)(cmax + bcol0 + bj * HALF + 4 * n);
#pragma unroll
        for (int ai = 0; ai < 2; ++ai)
#pragma unroll
            for (int m = 0; m < 4; ++m) sav[ai][m] = sA[row0 + ai * HALF + m * 16];
        asm volatile("" : "+v"(craw[0][0]), "+v"(craw[0][1]), "+v"(craw[1][0]), "+v"(craw[1][1]), "+v"(sav[0][0]), "+v"(sav[0][1]), "+v"(sav[0][2]), "+v"(sav[0][3]), "+v"(sav[1][0]), "+v"(sav[1][1]), "+v"(sav[1][2]), "+v"(sav[1][3]));
        f32x4 sb[2][2];
#pragma unroll
        for (int bj = 0; bj < 2; ++bj)
#pragma unroll
            for (int n = 0; n < 2; ++n) { const u32x4 c = craw[bj][n];
                sb[bj][n] = (f32x4){__uint_as_float(c[0]), __uint_as_float(c[1]), __uint_as_float(c[2]), __uint_as_float(c[3])} * (1.0f / 127.0f); }
#pragma unroll
        for (int ai = 0; ai < 2; ++ai)
#pragma unroll
            for (int m = 0; m < 4; ++m) { const int r = row0 + ai * HALF + m * 16; const float sa = sav[ai][m];
                const f32x4 g0 = i2f4(acc[ai][0][m][0]) * (sb[0][0] * sa), g1 = i2f4(acc[ai][0][m][1]) * (sb[0][1] * sa);
                const f32x4 u0 = i2f4(acc[ai][1][m][0]) * (sb[1][0] * sa), u1 = i2f4(acc[ai][1][m][1]) * (sb[1][1] * sa);
                f32x2 v[4];
                v[0] = silu_mul_pk((f32x2){g0[0], g0[1]}, (f32x2){u0[0], u0[1]}); v[1] = silu_mul_pk((f32x2){g0[2], g0[3]}, (f32x2){u0[2], u0[3]});
                v[2] = silu_mul_pk((f32x2){g1[0], g1[1]}, (f32x2){u1[0], u1[1]}); v[3] = silu_mul_pk((f32x2){g1[2], g1[3]}, (f32x2){u1[2], u1[3]});
                float mx = 0.f;
#pragma unroll
                for (int e = 0; e < 4; ++e) mx = fmaxf(mx, fmaxf(fabsf(v[e].x), fabsf(v[e].y)));
                { auto r_ = __builtin_amdgcn_permlane16_swap(__float_as_uint(mx), __float_as_uint(mx), false, false); mx = fmaxf(__uint_as_float(r_[0]), __uint_as_float(r_[1])); }
                { auto r_ = __builtin_amdgcn_permlane32_swap(__float_as_uint(mx), __float_as_uint(mx), false, false); mx = fmaxf(__uint_as_float(r_[0]), __uint_as_float(r_[1])); }
                const float inv = mx > 0.f ? 127.0f * __builtin_amdgcn_rcpf(mx) : 0.f;
                unsigned q[8];
#pragma unroll
                for (int e = 0; e < 4; ++e) { const f32x2 y = v[e] * inv + (12582912.0f + 128.0f); q[2 * e] = __float_as_uint(y.x); q[2 * e + 1] = __float_as_uint(y.y); }
                typedef unsigned u32x2 __attribute__((ext_vector_type(2)));
                u32x2 w; w.x = __builtin_amdgcn_perm(__builtin_amdgcn_perm(q[3], q[2], 0x0c0c0400u), __builtin_amdgcn_perm(q[1], q[0], 0x0c0c0400u), 0x05040100u);
                w.y = __builtin_amdgcn_perm(__builtin_amdgcn_perm(q[7], q[6], 0x0c0c0400u), __builtin_amdgcn_perm(q[5], q[4], 0x0c0c0400u), 0x05040100u);
                *(u32x2*)(Q + (size_t)r * ldc + col0) = w;
                if (fq == 0) { lsc[(size_t)r * nls + u.pn * 4 + wc] = mx * (1.0f / 127.0f); atomicMax(rowmax + r, __float_as_uint(mx)); } }
    }
};
struct EpiNull {
    static constexpr bool PERM = true, AFTER_DRAIN = false;
    float* O;
    __device__ __forceinline__ void operator()(const f32x4 (&acc)[2][2][4][2], const Unit& u, int wr, int wc, int fr, int fq) const {
        f32x4 s = (f32x4){0.f, 0.f, 0.f, 0.f};
#pragma unroll
        for (int ai = 0; ai < 2; ++ai)
#pragma unroll
            for (int bj = 0; bj < 2; ++bj)
#pragma unroll
                for (int m = 0; m < 4; ++m)
#pragma unroll
                    for (int n = 0; n < 2; ++n) s += acc[ai][bj][m][n];
        if (s[0] + s[1] + s[2] + s[3] == 1.2345e-33f) O[u.pm * 7 + u.pn + fr] = s[0];
    }
};
template <class Epi, class Sched, bool ALIGN_EPI = false, bool SP2 = false, int MK = 0>
__device__ __forceinline__ void gemm_phase(PG8_LAS unsigned char* lds, const Gemm g, const Sched& S, const Epi& E) {
    const int tid = threadIdx.x, wid = __builtin_amdgcn_readfirstlane(tid >> 6), lane = tid & 63, wr = wid >> 2, wc = wid & 3, fr = lane & 15, fq = lane >> 4;
    const int K = g.K, nt = K / BK;
    unsigned voffA[2], voffB[2];
#pragma unroll
    for (int i = 0; i < 2; ++i) { int R, C; stage_rc(tid * 16 + i * 8192, R, C); const int Rb = Epi::PERM ? ((R & ~31) + perm32(R & 31)) : R;
        voffA[i] = (unsigned)(R * K + C) * 2u; voffB[i] = (unsigned)(Rb * K + C) * 2u; }
    const size_t kstep = (size_t)(BK * 2);
    const size_t hstep = (size_t)HALF * K * 2;
    const size_t tstep = 2 * hstep;
    const unsigned ldsw = (unsigned)wid * 1024u;
    const int aoff = lds_byte(wr * 64 + fr, fq * 8), boff = lds_byte(wc * 32 + fr, fq * 8);
#define PG8_SA(b, h) (((b) * 2 + (h)) * HTB)
#define PG8_SB(b, h) ((4 + (b) * 2 + (h)) * HTB)
#define PG8_STAGE(bufoff, gbase, voff) do { _Pragma("unroll") for (int _i = 0; _i < 2; ++_i) \
        __builtin_amdgcn_global_load_lds((const unsigned*)((const char*)(gbase) + (voff)[_i]), (PG8_LAS unsigned*)(lds + (bufoff) + ldsw + _i * 8192), 16, 0, 0); } while (0)
#define PG8_LDA(dst, b, h) do { _Pragma("unroll") for (int m = 0; m < 4; ++m) _Pragma("unroll") for (int k = 0; k < 2; ++k) dst[m][k] = *(const PG8_LAS bf16x8*)(lds + PG8_SA(b, h) + aoff + m * 2048 + k * 1024); } while (0)
#define PG8_LDB(dst, b, h) do { _Pragma("unroll") for (int n = 0; n < 2; ++n) _Pragma("unroll") for (int k = 0; k < 2; ++k) dst[n][k] = *(const PG8_LAS bf16x8*)(lds + PG8_SB(b, h) + boff + n * 2048 + k * 1024); } while (0)
#define PG8_MMA(ai, bj, At, Bt) do { __builtin_amdgcn_s_setprio(1); _Pragma("unroll") for (int m = 0; m < 4; ++m) _Pragma("unroll") for (int n = 0; n < 2; ++n) _Pragma("unroll") for (int k = 0; k < 2; ++k) \
        { if constexpr (MK == 0) acc[ai][bj][m][n] = __builtin_amdgcn_mfma_f32_16x16x32_bf16(Bt[n][k], At[m][k], acc[ai][bj][m][n], 0, 0, 0); \
          else acc[ai][bj][m][n] = __builtin_bit_cast(f32x4, __builtin_amdgcn_mfma_i32_16x16x64_i8(__builtin_bit_cast(i32x4, Bt[n][k]), __builtin_bit_cast(i32x4, At[m][k]), __builtin_bit_cast(i32x4, acc[ai][bj][m][n]), 0, 0, 0)); } \
        __builtin_amdgcn_s_setprio(0); } while (0)
#define PG8_WAIT_V(n) asm volatile("s_waitcnt vmcnt(" #n ")" ::: "memory")
#define PG8_WAIT_L(n) asm volatile("s_waitcnt lgkmcnt(" #n ")" ::: "memory")
#define PG8_BAR __builtin_amdgcn_s_barrier()
#define PG8_SCHED __builtin_amdgcn_sched_barrier(0)
    Unit cur, nxt; int ui = 0;
    if (!S.next(0, cur)) return;
    f32x4 acc[2][2][4][2];
#pragma unroll
    for (int a = 0; a < 2; ++a)
#pragma unroll
        for (int b = 0; b < 2; ++b)
#pragma unroll
            for (int m = 0; m < 4; ++m)
#pragma unroll
                for (int n = 0; n < 2; ++n) acc[a][b][m][n] = (f32x4){0.f, 0.f, 0.f, 0.f};
    bf16x8 At[4][2], B0[2][2], B1[2][2];
    const char* cA = (const char*)g.A + (size_t)cur.pm * tstep; const char* cB = (const char*)g.Bt + (size_t)cur.pn * tstep;
    S.a_ready(cur);
    if constexpr (SP2) {
        PG8_STAGE(PG8_SB(0, 0), cB, voffB); PG8_STAGE(PG8_SB(0, 1), cB + hstep, voffB); PG8_STAGE(PG8_SA(0, 0), cA, voffA); PG8_STAGE(PG8_SA(0, 1), cA + hstep, voffA);
        if (wr == 1) PG8_BAR;
        PG8_WAIT_V(2); PG8_BAR;
        PG8_STAGE(PG8_SB(1, 0), cB + kstep, voffB); PG8_STAGE(PG8_SA(1, 0), cA + kstep, voffA); PG8_STAGE(PG8_SB(1, 1), cB + hstep + kstep, voffB);
        PG8_WAIT_V(6); PG8_BAR;
    } else {
        PG8_STAGE(PG8_SB(0, 0), cB, voffB); PG8_STAGE(PG8_SA(0, 0), cA, voffA); PG8_STAGE(PG8_SB(0, 1), cB + hstep, voffB); PG8_STAGE(PG8_SA(0, 1), cA + hstep, voffA);
        if (wr == 1) PG8_BAR;
        PG8_WAIT_V(4); PG8_BAR;
        PG8_STAGE(PG8_SB(1, 0), cB + kstep, voffB); PG8_STAGE(PG8_SA(1, 0), cA + kstep, voffA); PG8_STAGE(PG8_SB(1, 1), cB + hstep + kstep, voffB);
        PG8_WAIT_V(6); PG8_BAR;
    }
    for (;;) {
        const bool has_next = S.next(ui + 1, nxt);
        const char* nA = has_next ? (const char*)g.A + (size_t)nxt.pm * tstep : cA; const char* nB = has_next ? (const char*)g.Bt + (size_t)nxt.pn * tstep : cB;
        for (int t = 0; t < nt; t += 2) {
            const bool last = (t == nt - 2);
            const char* a1 = cA + (size_t)(t + 1) * kstep;
            const char* a2 = last ? nA : cA + (size_t)(t + 2) * kstep; const char* b2 = last ? nB : cB + (size_t)(t + 2) * kstep;
            const char* a3 = a2 + kstep; const char* b3 = b2 + kstep;
            if (last && has_next) S.a_ready(nxt);
            if constexpr (SP2) {
            PG8_LDB(B0, 0, 0); PG8_LDB(B1, 0, 1); PG8_SCHED; PG8_LDA(At, 0, 0); PG8_STAGE(PG8_SA(1, 1), a1 + hstep, voffA);
            PG8_WAIT_V(8); PG8_WAIT_L(0); PG8_BAR; PG8_MMA(0, 0, At, B0); PG8_MMA(0, 1, At, B1); PG8_BAR; PG8_SCHED;
            PG8_LDA(At, 0, 1); PG8_STAGE(PG8_SB(0, 0), b2, voffB); PG8_STAGE(PG8_SB(0, 1), b2 + hstep, voffB); PG8_STAGE(PG8_SA(0, 0), a2, voffA);
            PG8_WAIT_V(8); PG8_WAIT_L(0); PG8_BAR; PG8_MMA(1, 0, At, B0); PG8_MMA(1, 1, At, B1); PG8_BAR; PG8_SCHED;
            PG8_LDB(B0, 1, 0); PG8_LDB(B1, 1, 1); PG8_SCHED; PG8_LDA(At, 1, 0); PG8_STAGE(PG8_SA(0, 1), a2 + hstep, voffA);
            PG8_WAIT_V(8); PG8_WAIT_L(0); PG8_BAR; PG8_MMA(0, 0, At, B0); PG8_MMA(0, 1, At, B1); PG8_BAR; PG8_SCHED;
            PG8_LDA(At, 1, 1); PG8_STAGE(PG8_SB(1, 0), b3, voffB); PG8_STAGE(PG8_SB(1, 1), b3 + hstep, voffB); PG8_STAGE(PG8_SA(1, 0), a3, voffA);
            PG8_WAIT_V(8); PG8_WAIT_L(0); PG8_BAR; PG8_MMA(1, 0, At, B0); PG8_MMA(1, 1, At, B1); PG8_BAR; PG8_SCHED;
            } else {
            PG8_LDB(B0, 0, 0); PG8_SCHED; PG8_LDA(At, 0, 0); PG8_STAGE(PG8_SA(1, 1), a1 + hstep, voffA);
            PG8_WAIT_L(8); PG8_BAR; PG8_WAIT_L(0); PG8_MMA(0, 0, At, B0); PG8_BAR; PG8_SCHED;
            PG8_LDB(B1, 0, 1); PG8_STAGE(PG8_SB(0, 0), b2, voffB);
            PG8_BAR; PG8_WAIT_L(0); PG8_MMA(0, 1, At, B1); PG8_BAR;
            PG8_LDA(At, 0, 1); PG8_STAGE(PG8_SA(0, 0), a2, voffA);
            PG8_BAR; PG8_WAIT_L(0); PG8_MMA(1, 0, At, B0); PG8_BAR; PG8_SCHED;
            PG8_STAGE(PG8_SB(0, 1), b2 + hstep, voffB);
            PG8_WAIT_V(6); PG8_BAR; PG8_MMA(1, 1, At, B1); PG8_BAR;
            PG8_LDB(B0, 1, 0); PG8_SCHED; PG8_LDA(At, 1, 0); PG8_STAGE(PG8_SA(0, 1), a2 + hstep, voffA);
            PG8_WAIT_L(8); PG8_BAR; PG8_WAIT_L(0); PG8_MMA(0, 0, At, B0); PG8_BAR; PG8_SCHED;
            PG8_LDB(B1, 1, 1); PG8_STAGE(PG8_SB(1, 0), b3, voffB);
            PG8_BAR; PG8_WAIT_L(0); PG8_MMA(0, 1, At, B1); PG8_BAR;
            PG8_LDA(At, 1, 1); PG8_STAGE(PG8_SA(1, 0), a3, voffA);
            PG8_BAR; PG8_WAIT_L(0); PG8_MMA(1, 0, At, B0); PG8_BAR; PG8_SCHED;
            PG8_STAGE(PG8_SB(1, 1), b3 + hstep, voffB);
            PG8_WAIT_V(6); PG8_BAR; PG8_MMA(1, 1, At, B1); PG8_BAR;
            }
        }
        if constexpr (ALIGN_EPI) { if (wr == 0) PG8_BAR; }
        if constexpr (!Epi::AFTER_DRAIN) { E(acc, cur, wr, wc, fr, fq); S.done(cur); }
        if (!has_next) break;
#pragma unroll
        for (int a = 0; a < 2; ++a)
#pragma unroll
            for (int b = 0; b < 2; ++b)
#pragma unroll
                for (int m = 0; m < 4; ++m)
#pragma unroll
                    for (int n = 0; n < 2; ++n) acc[a][b][m][n] = (f32x4){0.f, 0.f, 0.f, 0.f};
        cur = nxt; cA = nA; cB = nB; ++ui;
        if constexpr (ALIGN_EPI) { if (wr == 1) PG8_BAR; }
    }
    PG8_WAIT_V(0);
    if constexpr (!ALIGN_EPI) { if (wr == 0) PG8_BAR; }
    PG8_BAR;
    if constexpr (Epi::AFTER_DRAIN) { E.fused(acc, cur, wr, wc, fr, fq, lds, wid, lane); S.done(cur); }
#undef PG8_SA
#undef PG8_SB
#undef PG8_STAGE
#undef PG8_LDA
#undef PG8_LDB
#undef PG8_MMA
#undef PG8_WAIT_V
#undef PG8_WAIT_L
#undef PG8_BAR
#undef PG8_SCHED
}
}

namespace att {
#define ATT_LAS __attribute__((address_space(3)))
typedef unsigned short bf16;
typedef short bf16x8 __attribute__((ext_vector_type(8)));
typedef short s16x4 __attribute__((ext_vector_type(4)));
typedef float f32x16 __attribute__((ext_vector_type(16)));
typedef float f32x4 __attribute__((ext_vector_type(4)));
typedef unsigned u32x4 __attribute__((ext_vector_type(4)));
typedef unsigned u32x2 __attribute__((ext_vector_type(2)));
constexpr int SHM_T = 16384;
constexpr int OFF_V = 0, OFF_K = 2 * SHM_T, OFF_KM = 4 * SHM_T, OFF_WS = OFF_KM + 8192, ATT_LDS = OFF_WS + 8 * 64 * 4;
constexpr int PS = 5632;
constexpr int OPITCH = 4096;
constexpr float LOG2E = 1.4426950408889634f;
constexpr float C2 = 0.08838834764831845f * 1.4426950408889634f;
constexpr float THR = 8.f;
#define ATT_KSWZ(row, colB) ((row) * 256 + ((colB) ^ (((row) & 7) << 4)))
__device__ __forceinline__ int v_st(int k, int c) { const int kk = (k & ~0xC) | ((k & 4) << 1) | ((k & 8) >> 1); return ((kk >> 3) * 4 + (c >> 5)) * 512 + ((kk & 7) * 32 + (c & 31)) * 2; }
__device__ __forceinline__ int v_rd_base(int lane) { return ((lane & 3) << 3) | (((lane >> 2) & 3) << 6) | (((lane >> 4) & 1) << 5) | (((lane >> 5) & 1) << 8); }
constexpr int v_rd_off(int d0, int ks, int half) { return d0 * 512 + ks * 4096 + half * 2048; }
__device__ __forceinline__ int crow(int r, int hi) { return (r & 3) + 8 * (r >> 2) + 4 * hi; }
__device__ __forceinline__ unsigned cvtpk(float lo, float hi) { unsigned r; asm volatile("v_cvt_pk_bf16_f32 %0, %1, %2" : "=v"(r) : "v"(lo), "v"(hi)); return r; }

__device__ __forceinline__ void pv_tile(f32x16* o, unsigned vb, bf16x8 pa0, bf16x8 pa1, bf16x8 pa2, bf16x8 pa3) {
#define ATT_TRRD(dst, off) asm volatile("ds_read_b64_tr_b16 %0, %1 offset:%2" : "=&v"(dst) : "v"(vb), "i"(off) : "memory")
#define ATT_TR8(L, ks) do { ATT_TRRD(L[0], v_rd_off(0, ks, 0)); ATT_TRRD(L[1], v_rd_off(0, ks, 1)); ATT_TRRD(L[2], v_rd_off(1, ks, 0)); ATT_TRRD(L[3], v_rd_off(1, ks, 1)); \
        ATT_TRRD(L[4], v_rd_off(2, ks, 0)); ATT_TRRD(L[5], v_rd_off(2, ks, 1)); ATT_TRRD(L[6], v_rd_off(3, ks, 0)); ATT_TRRD(L[7], v_rd_off(3, ks, 1)); } while (0)
#define ATT_WAITV(n, L) asm volatile("s_waitcnt lgkmcnt(" #n ")" : "+v"(L[0]), "+v"(L[1]), "+v"(L[2]), "+v"(L[3]), "+v"(L[4]), "+v"(L[5]), "+v"(L[6]), "+v"(L[7]) :: "memory")
#define ATT_PV4(L, pa) do { _Pragma("unroll") for (int d0 = 0; d0 < 4; ++d0) \
        o[d0] = __builtin_amdgcn_mfma_f32_32x32x16_bf16(pa, (bf16x8){L[2 * d0][0], L[2 * d0][1], L[2 * d0][2], L[2 * d0][3], L[2 * d0 + 1][0], L[2 * d0 + 1][1], L[2 * d0 + 1][2], L[2 * d0 + 1][3]}, o[d0], 0, 0, 0); } while (0)
    s16x4 A[8], B[8];
    ATT_TR8(A, 0); ATT_TR8(B, 1); ATT_WAITV(8, A); ATT_PV4(A, pa0);
    ATT_TR8(A, 2); ATT_WAITV(8, B); ATT_PV4(B, pa1);
    ATT_TR8(B, 3); ATT_WAITV(8, A); ATT_PV4(A, pa2);
    ATT_WAITV(0, B); ATT_PV4(B, pa3);
#undef ATT_PV4
#undef ATT_WAITV
#undef ATT_TR8
#undef ATT_TRRD
}

template <int MODE, int VAR = 0>
__device__ __forceinline__ void attn_unit(ATT_LAS unsigned char* lds, const bf16* proj, bf16* O, const float* kmean, const float* sinks, int b, int kvh, int t0) {
    int tid_ = threadIdx.x; asm volatile("" : "+v"(tid_));
    const int tid = tid_, wid = __builtin_amdgcn_readfirstlane(tid >> 6), lane = tid & 63, r32 = lane & 31, hi = lane >> 5;
    int head, tw0, qcol, kcol, vcol, ocol;
    if (MODE == 0) { head = kvh * 8 + wid; tw0 = t0; qcol = head * 128; kcol = 2048 + kvh * 128; vcol = 2304 + kvh * 128; ocol = head * 128; }
    else { head = kvh * 4 + (wid >> 1); tw0 = t0 + 32 * (wid & 1); qcol = 2560 + head * 128; kcol = 4608 + kvh * 128; vcol = 5120 + kvh * 128; ocol = 2048 + head * 128; }
    const int tq = tw0 + r32;
    const float slope2 = exp2f(-0.5f * (float)(head + 1)) * LOG2E;
    const size_t rowbase = (size_t)b * 4096;
    bf16x8 qr[8];
    { const bf16* qp = proj + (rowbase + tq) * PS + qcol + hi * 8;
#pragma unroll
      for (int d0 = 0; d0 < 8; ++d0) qr[d0] = *(const bf16x8*)(qp + d0 * 16); }
    ATT_LAS float* wsf = (ATT_LAS float*)(lds + OFF_WS) + wid * 64; ATT_LAS float* li_l = wsf; ATT_LAS float* al_l = wsf + 32;
    const float NEG = -__builtin_inff();
    unsigned selmask = 0u; const int own_blk = t0 >> 8;
    int j_lo, j_hi;
    if (MODE == 0) { j_lo = (t0 - 127) > 0 ? ((t0 - 127) >> 6) : 0; j_hi = ((t0 + 31) >> 6) + 1; }
    else { j_lo = 0; j_hi = (t0 >> 6) + 1; }
    const int NT = j_hi - j_lo;
    unsigned kgo[2], vgo[2];
#pragma unroll
    for (int i = 0; i < 2; ++i) { const int L = (i * 8 + wid) * 1024 + lane * 16;
        { const int row = L >> 8, colB = (L & 255) ^ ((row & 7) << 4); kgo[i] = (unsigned)(row * PS * 2 + colB); }
        { const int sub = L >> 9, e = (L & 511) >> 1, kk = ((sub >> 2) << 3) | (e >> 5), c = ((sub & 3) << 5) | (e & 31), k = (kk & ~0xC) | ((kk & 4) << 1) | ((kk & 8) >> 1); vgo[i] = (unsigned)(k * PS * 2 + c * 2); } }
    const unsigned char* kgb = (const unsigned char*)(proj + rowbase * PS + kcol) + (size_t)j_lo * 64 * PS * 2;
    const unsigned char* vgb = (const unsigned char*)(proj + rowbase * PS + vcol) + (size_t)j_lo * 64 * PS * 2;
#define ATT_DMA_K(t, bf) do { if (VAR & 8) break; const unsigned char* g_ = kgb + (size_t)(t) * (64 * PS * 2); _Pragma("unroll") for (int i = 0; i < 2; ++i) \
        __builtin_amdgcn_global_load_lds((const unsigned*)(g_ + kgo[i]), (ATT_LAS unsigned*)(lds + OFF_K + (bf) + (i * 8 + wid) * 1024), 16, 0, 0); } while (0)
#define ATT_DMA_V(t, bf) do { if (VAR & 8) break; const unsigned char* g_ = vgb + (size_t)(t) * (64 * PS * 2); _Pragma("unroll") for (int i = 0; i < 2; ++i) \
        __builtin_amdgcn_global_load_lds((const unsigned*)(g_ + vgo[i]), (ATT_LAS unsigned*)(lds + OFF_V + (bf) + (i * 8 + wid) * 1024), 16, 0, 0); } while (0)
    f32x4 kmv = {};
    if (MODE == 1) kmv = *(const f32x4*)(kmean + ((size_t)(b * 4 + kvh) * 16 + (tid >> 5)) * 128 + (tid & 31) * 4);
    ATT_DMA_K(0, 0); ATT_DMA_V(0, 0);
    if (NT > 1) ATT_DMA_K(1, SHM_T);
    if (MODE == 1) {
        {
            const int n = tid >> 5, c4 = (tid & 31) * 4;
            const f32x4 v = kmv;
            const unsigned h01 = cvtpk(v[0], v[1]), h23 = cvtpk(v[2], v[3]);
            const float r0 = v[0] - __uint_as_float(h01 << 16), r1 = v[1] - __uint_as_float(h01 & 0xffff0000u), r2 = v[2] - __uint_as_float(h23 << 16), r3 = v[3] - __uint_as_float(h23 & 0xffff0000u);
            const unsigned l01 = cvtpk(r0, r1), l23 = cvtpk(r2, r3);
            const int off = n * 256 + ((c4 * 2) ^ ((n & 7) << 4));
            *(ATT_LAS u32x2*)(lds + OFF_KM + off) = (u32x2){h01, h23};
            *(ATT_LAS u32x2*)(lds + OFF_KM + off + 16 * 256) = (u32x2){l01, l23};
        }
        asm volatile("s_waitcnt lgkmcnt(0)" ::: "memory"); __builtin_amdgcn_s_barrier(); asm volatile("" ::: "memory");
        f32x16 gp = {};
#pragma unroll
        for (int d0 = 0; d0 < 8; ++d0) { const bf16x8 kf = *(const ATT_LAS bf16x8*)(lds + OFF_KM + ATT_KSWZ(r32, d0 * 32 + hi * 16));
            gp = __builtin_amdgcn_mfma_f32_32x32x16_bf16(kf, qr[d0], gp, 0, 0, 0); }
        float own[8], par[8], gn[16];
#pragma unroll
        for (int i = 0; i < 8; ++i) own[i] = gp[i] + gp[i + 8];
#pragma unroll
        for (int i = 0; i < 8; ++i) { auto rr = __builtin_amdgcn_permlane32_swap(__float_as_uint(own[i]), __float_as_uint(own[i]), false, false); par[i] = __uint_as_float(hi ? rr[0] : rr[1]); }
#pragma unroll
        for (int i = 0; i < 8; ++i) { const int nlo = (i & 3) + 8 * (i >> 2); gn[nlo] = hi ? par[i] : own[i]; gn[nlo + 4] = hi ? own[i] : par[i]; }
#pragma unroll
        for (int n = 0; n < 16; ++n) gn[n] = (n < own_blk) ? gn[n] : NEG;
#pragma unroll
        for (int k = 0; k < 3; ++k) { float best = NEG; int bi = -1;
#pragma unroll
            for (int n = 0; n < 16; ++n) { const bool gt = gn[n] > best; best = gt ? gn[n] : best; bi = gt ? n : bi; }
            if (bi >= 0) selmask |= 1u << bi;
#pragma unroll
            for (int n = 0; n < 16; ++n) gn[n] = (n == bi) ? NEG : gn[n]; }
    }
#pragma unroll
    for (int d0 = 0; d0 < 8; ++d0) { u32x4 w = __builtin_bit_cast(u32x4, qr[d0]);
#pragma unroll
        for (int e = 0; e < 4; ++e) w[e] = cvtpk(__uint_as_float(w[e] << 16) * C2, __uint_as_float(w[e] & 0xffff0000u) * C2);
        qr[d0] = __builtin_bit_cast(bf16x8, w); }
    float m_reg, l_reg;
    if (MODE == 0) { m_reg = sinks[head] * LOG2E; l_reg = 1.f; } else { m_reg = -1e30f; l_reg = 0.f; }
    f32x16 o[4] = {};
    f32x16 sbv;
#pragma unroll
    for (int i = 0; i < 16; ++i) sbv[i] = slope2 * (float)((i & 3) + 8 * (i >> 2));
    const float s32 = __builtin_bit_cast(float, __builtin_amdgcn_readfirstlane(__builtin_bit_cast(int, slope2 * 32.0f)));
    const unsigned vb0 = (unsigned)(size_t)(lds + OFF_V) + (unsigned)v_rd_base(lane);
    unsigned ka[4];
#pragma unroll
    for (int dd = 0; dd < 4; ++dd) ka[dd] = (unsigned)(size_t)(lds + OFF_K) + (unsigned)ATT_KSWZ(r32, dd * 32 + hi * 16);
#define ATT_LDK(dst, dd, off) asm volatile("ds_read_b128 %0, %1 offset:%2" : "=&v"(dst) : "v"(kt[dd]), "i"(off) : "memory")
#define ATT_LDK4(x0, x1, x2, x3, d0) do { ATT_LDK(x0, (d0) & 3, ((d0) >> 2) * 128); ATT_LDK(x1, (d0) & 3, ((d0) >> 2) * 128 + 8192); \
        ATT_LDK(x2, ((d0) + 1) & 3, (((d0) + 1) >> 2) * 128); ATT_LDK(x3, ((d0) + 1) & 3, (((d0) + 1) >> 2) * 128 + 8192); } while (0)
#define ATT_WAITK(n, x0, x1, x2, x3) asm volatile("s_waitcnt lgkmcnt(" #n ")" : "+v"(x0), "+v"(x1), "+v"(x2), "+v"(x3) :: "memory")
#define ATT_MM4(P0, P1, x0, x1, x2, x3, d0) do { P0 = __builtin_amdgcn_mfma_f32_32x32x16_bf16(x0, qr[d0], P0, 0, 0, 0); P1 = __builtin_amdgcn_mfma_f32_32x32x16_bf16(x1, qr[d0], P1, 0, 0, 0); \
        P0 = __builtin_amdgcn_mfma_f32_32x32x16_bf16(x2, qr[(d0) + 1], P0, 0, 0, 0); P1 = __builtin_amdgcn_mfma_f32_32x32x16_bf16(x3, qr[(d0) + 1], P1, 0, 0, 0); } while (0)
#define ATT_QK(P0, P1, bo) do { P0 = sbv; P1 = sbv; if (VAR & 2) { P0[0] = (float)(bo); break; } bf16x8 a0_, a1_, a2_, a3_, c0_, c1_, c2_, c3_; unsigned kt[4]; \
        _Pragma("unroll") for (int dd = 0; dd < 4; ++dd) kt[dd] = ka[dd] + (unsigned)(bo); \
        ATT_LDK4(a0_, a1_, a2_, a3_, 0); ATT_LDK4(c0_, c1_, c2_, c3_, 2); ATT_WAITK(4, a0_, a1_, a2_, a3_); ATT_MM4(P0, P1, a0_, a1_, a2_, a3_, 0); \
        ATT_LDK4(a0_, a1_, a2_, a3_, 4); ATT_WAITK(4, c0_, c1_, c2_, c3_); ATT_MM4(P0, P1, c0_, c1_, c2_, c3_, 2); \
        ATT_LDK4(c0_, c1_, c2_, c3_, 6); ATT_WAITK(4, a0_, a1_, a2_, a3_); ATT_MM4(P0, P1, a0_, a1_, a2_, a3_, 4); \
        ATT_WAITK(0, c0_, c1_, c2_, c3_); ATT_MM4(P0, P1, c0_, c1_, c2_, c3_, 6); } while (0)
#define ATT_START_SM(P0, P1, t, al) do { if (VAR & 4) { al = 1.f; break; } const int kbase_ = (j_lo + (t)) * 64; const int dq_ = kbase_ + 4 * hi - tq;     \
        float basef_ = slope2 * (float)dq_; bool emask_; unsigned W_; \
        if (MODE == 0) { emask_ = true; W_ = 128u; } \
        else { const int n_ = kbase_ >> 8; if (n_ < own_blk) { emask_ = false; W_ = 0u; if (((selmask >> n_) & 1u) == 0u) basef_ = NEG; } else { emask_ = true; W_ = 0x40000000u; } } \
        if (emask_) { _Pragma("unroll") for (int r = 0; r < 16; ++r) { const int c_ = (r & 3) + 8 * (r >> 2); \
            if ((unsigned)(-dq_ - c_) >= W_) P0[r] = NEG; if ((unsigned)(-dq_ - c_ - 32) >= W_) P1[r] = NEG; } } \
        float pm0_ = P0[0], pm1_ = P1[0]; \
        _Pragma("unroll") for (int r = 1; r < 16; ++r) { pm0_ = fmaxf(pm0_, P0[r]); pm1_ = fmaxf(pm1_, P1[r]); } \
        float pmax_ = fmaxf(pm0_, pm1_ + s32) + basef_;                       \
        { auto rr_ = __builtin_amdgcn_permlane32_swap(__float_as_uint(pmax_), __float_as_uint(pmax_), false, false); pmax_ = fmaxf(__uint_as_float(rr_[0]), __uint_as_float(rr_[1])); } \
        float mn_; \
        if (__all((pmax_ - m_reg) <= THR)) { mn_ = m_reg; al = 1.f; } else { mn_ = fmaxf(m_reg, pmax_); al = (MODE != 0 && m_reg == -1e30f) ? 1.f : __builtin_amdgcn_exp2f(m_reg - mn_); m_reg = mn_; }     \
        const float off0_ = basef_ - mn_, off1_ = off0_ + s32; \
        _Pragma("unroll") for (int r = 0; r < 16; ++r) { P0[r] = __builtin_amdgcn_exp2f(P0[r] + off0_); P1[r] = P1[r] + off1_; } } while (0)
#define ATT_PK4(P, B_, OUT) do { const unsigned a0_ = cvtpk(P[B_+0], P[B_+1]), a1_ = cvtpk(P[B_+2], P[B_+3]), b0_ = cvtpk(P[B_+4], P[B_+5]), b1_ = cvtpk(P[B_+6], P[B_+7]); \
        auto r0_ = __builtin_amdgcn_permlane32_swap(a0_, b0_, false, false); auto r1_ = __builtin_amdgcn_permlane32_swap(a1_, b1_, false, false); \
        u32x4 w_ = {r0_[0], r1_[0], r0_[1], r1_[1]}; OUT = __builtin_bit_cast(bf16x8, w_); } while (0)
#define ATT_FINISH_SM(P0, P1, al) do { if (VAR & 4) { l_reg += P0[0]; ATT_PK4(P0, 0, pa0); ATT_PK4(P0, 8, pa1); ATT_PK4(P1, 0, pa2); ATT_PK4(P1, 8, pa3); break; } _Pragma("unroll") for (int r = 0; r < 16; ++r) P1[r] = __builtin_amdgcn_exp2f(P1[r]); \
        float ps_ = 0.f; _Pragma("unroll") for (int r = 0; r < 16; ++r) ps_ += P0[r]; _Pragma("unroll") for (int r = 0; r < 16; ++r) ps_ += P1[r]; \
        { auto rr_ = __builtin_amdgcn_permlane32_swap(__float_as_uint(ps_), __float_as_uint(ps_), false, false); ps_ = __uint_as_float(rr_[0]) + __uint_as_float(rr_[1]); } \
        l_reg = l_reg * (al) + ps_; ATT_PK4(P0, 0, pa0); ATT_PK4(P0, 8, pa1); ATT_PK4(P1, 0, pa2); ATT_PK4(P1, 8, pa3); } while (0)
#define ATT_RESC(al) do { if (__any((al) < 1.f)) { if (hi == 0) al_l[r32] = (al); asm volatile("s_waitcnt lgkmcnt(0)" ::: "memory"); float av_[16]; \
        _Pragma("unroll") for (int r = 0; r < 16; ++r) av_[r] = al_l[crow(r, hi)]; \
        _Pragma("unroll") for (int d = 0; d < 4; ++d) _Pragma("unroll") for (int r = 0; r < 16; ++r) o[d][r] *= av_[r]; \
        asm volatile("s_waitcnt lgkmcnt(0)" ::: "memory"); } } while (0)
    f32x16 pX0, pX1, pY0, pY1; float alX = 1.f, alY = 1.f; bf16x8 pa0, pa1, pa2, pa3;
    __syncthreads();
    ATT_QK(pY0, pY1, 0);
    ATT_START_SM(pY0, pY1, 0, alY);
    __syncthreads();
    if (NT > 1) ATT_DMA_V(1, SHM_T);
    ATT_RESC(alY);
#pragma unroll 1
    for (int t = 1; t < NT; ++t) {
        const int bo = (t & 1) * SHM_T, bp = SHM_T - bo;
        if (t + 1 < NT) ATT_DMA_K(t + 1, bp);
        ATT_QK(pX0, pX1, bo);
        ATT_FINISH_SM(pY0, pY1, alY);
        if (!(VAR & 1)) pv_tile(o, vb0 + (unsigned)bp, pa0, pa1, pa2, pa3);
        ATT_START_SM(pX0, pX1, t, alX);
        __syncthreads();
        if (t + 1 < NT) ATT_DMA_V(t + 1, bp);
        ATT_RESC(alX);
        pY0 = pX0; pY1 = pX1; alY = alX;
    }
    ATT_FINISH_SM(pY0, pY1, alY); if (!(VAR & 1)) pv_tile(o, vb0 + (unsigned)(((NT - 1) & 1) * SHM_T), pa0, pa1, pa2, pa3);
#undef ATT_DMA_K
#undef ATT_DMA_V
#undef ATT_LDK
#undef ATT_LDK4
#undef ATT_WAITK
#undef ATT_MM4
#undef ATT_QK
#undef ATT_START_SM
#undef ATT_PK4
#undef ATT_FINISH_SM
#undef ATT_RESC
    if (hi == 0) li_l[r32] = l_reg; asm volatile("s_waitcnt lgkmcnt(0)" ::: "memory");
    float rli[16];
#pragma unroll
    for (int r = 0; r < 16; ++r) rli[r] = __builtin_amdgcn_rcpf(li_l[crow(r, hi)]);
    bf16* Ow = O + (rowbase + tw0) * OPITCH + ocol;
    const bool odd = (r32 & 1) != 0;
#pragma unroll
    for (int r = 0; r < 16; ++r) { const int orow = crow(r, hi);
#pragma unroll
        for (int dp = 0; dp < 2; ++dp) { const float va = o[2 * dp][r] * rli[r], vb = o[2 * dp + 1][r] * rli[r];
            const float send = odd ? va : vb;
            const float recv = __builtin_bit_cast(float, __builtin_amdgcn_mov_dpp(__builtin_bit_cast(int, send), 0xB1, 0xf, 0xf, true));
            const float lo = odd ? recv : va, hi_ = odd ? vb : recv;
            *(unsigned*)(Ow + (size_t)orow * OPITCH + (2 * dp + (odd ? 1 : 0)) * 32 + (r32 & ~1)) = cvtpk(lo, hi_); } }
    __syncthreads();
}
}

#ifndef MK_N_LAUNCHES
#define MK_N_LAUNCHES 1
#endif
#ifndef PROBE_DUP
#define PROBE_DUP 0
#endif
#ifndef PROBE_PK
#define PROBE_PK 2048
#endif
#ifndef FFN1_I8
#define FFN1_I8 1
#endif
#ifndef FFN2_I8
#define FFN2_I8 1
#endif
#ifndef WOUT_I8
#define WOUT_I8 1
#endif
constexpr bool F1Q = FFN1_I8 != 0, F2Q = FFN2_I8 != 0, WOQ = WOUT_I8 != 0;
constexpr int N_PHASES = 16;
constexpr int N_LAUNCHES = MK_N_LAUNCHES;
constexpr int NWAVES = 8;
constexpr int D = 4096, NBATCH = 4, SEQ = 4096, M = NBATCH * SEQ, FF = 11008, DIN = 5632, NMODV = 9 * D  ;
constexpr int CSUB = 4;
constexpr float CSAFE = 1.25f;
#ifndef FILL_A
#define FILL_A 8
#endif
#ifndef FILL_B
#define FILL_B 10
#endif
#ifndef FILL_C
#define FILL_C 8
#endif
constexpr int FILLA = FILL_A, FILLB = FILL_B, FILLC = FILL_C;
constexpr int KS_ADA = 16;
constexpr float EPS = 1e-6f;

constexpr size_t MiB = 1u << 20;
constexpr size_t WS_CTL = 0, CTL_ZERO_BYTES = 1 * MiB;
constexpr size_t WS_MOD = 1 * MiB;
constexpr size_t WS_RSH = 1 * MiB + 768 * 1024;
constexpr size_t WS_RSA = 1 * MiB + 896 * 1024;
constexpr size_t WS_MODP = 2 * MiB;
constexpr size_t WS_KMEAN = 11 * MiB;
constexpr size_t WS_WGU1 = 12 * MiB;
constexpr size_t WS_WD1 = 184 * MiB;
constexpr size_t WS_WGU2 = 270 * MiB;
constexpr size_t WS_WD2 = 442 * MiB;
constexpr size_t WS_WIN = 528 * MiB;
constexpr size_t WS_WOUT = 572 * MiB;
constexpr size_t WS_H = 604 * MiB;
constexpr size_t WS_ACT = 732 * MiB;
constexpr size_t WS_Y = 1076 * MiB;
constexpr size_t WS_PROJ = 1204 * MiB;
constexpr size_t WS_O = 1380 * MiB;
constexpr size_t WS_ACT8 = 1508 * MiB;
constexpr size_t WS_XR = 1680 * MiB;
constexpr size_t WS_END = 1808 * MiB;
static_assert(WS_WGU1 + (size_t)2 * FF * D * 2 <= WS_WD1 && WS_WD1 + (size_t)D * FF * 2 <= WS_WGU2 && WS_WGU2 + (size_t)2 * FF * D * 2 <= WS_WD2 && WS_WD2 + (size_t)D * FF * 2 <= WS_WIN, "ws map 1");
static_assert(WS_WIN + (size_t)DIN * D * 2 <= WS_WOUT && WS_WOUT + (size_t)D * D * 2 <= WS_H && WS_H + (size_t)M * D * 2 <= WS_ACT && WS_ACT + (size_t)M * FF * 2 <= WS_Y, "ws map 2");
static_assert(WS_Y + (size_t)M * D * 2 <= WS_PROJ && WS_PROJ + (size_t)M * DIN * 2 <= WS_O && WS_O + (size_t)M * D * 2 <= WS_ACT8 && WS_ACT8 + (size_t)M * FF <= WS_XR && WS_XR + (size_t)M * D * 2 <= WS_END && WS_MODP + (size_t)KS_ADA * 4 * NMODV * 4 <= WS_KMEAN, "ws map 3");
static_assert(WS_MOD + (size_t)4 * NMODV * 4 <= WS_RSH && WS_RSH + (size_t)M * 4 <= WS_RSA && WS_RSA + (size_t)M * 4 <= WS_MODP, "ws map 4");
constexpr int CW_BAR = 4096;
constexpr int CW_ROWMAX2 = 16384, CW_ROWMAX1 = 32768;
constexpr int CW_CMAX2 = 65536, CW_CMAX1 = 98304;
constexpr int CMAX_DN = 22528;
#ifndef I8MASK_
#define I8MASK_ 0x3FFu
#endif
constexpr unsigned I8MASK = I8MASK_, BFMASK = ~I8MASK_ & 0x3FFFFFu;
constexpr int NT8 = __builtin_popcount(I8MASK), NI8 = 256 * NT8, NBF = DIN - NI8;
static_assert((I8MASK & ~0x3FFFFFu) == 0 && (I8MASK & 0x0FFC00u) == 0 && NT8 >= 1 && NT8 <= 21, "projection split");
constexpr int CW_CMAXI = 131072;
static_assert((size_t)(CW_CMAXI + NI8) * 4 <= CTL_ZERO_BYTES && CW_CMAX1 + CMAX_DN + D <= CW_CMAXI, "control map (projection)");
constexpr int CW_CMAXO = CW_CMAX2 + CMAX_DN + 4096;
static_assert(CW_BAR + 3456 <= CW_ROWMAX2 && CW_ROWMAX2 + M <= CW_ROWMAX1 && CW_ROWMAX1 + M <= CW_CMAX2 && 2 * FF <= CMAX_DN && CW_CMAXO + D <= CW_CMAX1 && (size_t)(CW_CMAX1 + CMAX_DN + D) * 4 <= CTL_ZERO_BYTES, "control map");

constexpr int WAVE_SCR = 64 * 65 * 4;
constexpr int LDSCTL_OFF = 135168, LDS_BYTES = 147456;
static_assert(NWAVES * WAVE_SCR <= LDSCTL_OFF && pg8::STAGE_BYTES <= LDSCTL_OFF && att::ATT_LDS <= LDSCTL_OFF, "LDS map");

#define GAS __attribute__((address_space(1)))
#define LAS __attribute__((address_space(3)))
typedef unsigned short bf16;
typedef unsigned v4u __attribute__((ext_vector_type(4)));
typedef unsigned v2u __attribute__((ext_vector_type(2)));
typedef float f32x4 __attribute__((ext_vector_type(4)));
#define LDS_WAIT() asm volatile("s_waitcnt lgkmcnt(0)" ::: "memory")
__device__ __forceinline__ unsigned pk2(float lo, float hi) { return pg8::cvt_pk_bf16(lo, hi); }
__device__ __forceinline__ float bf_lo(unsigned u) { return __uint_as_float(u << 16); }
__device__ __forceinline__ float bf_hi(unsigned u) { return __uint_as_float(u & 0xffff0000u); }

#define XB_TMO      128
#define XB_XCNT(j)  (256  + 64 * (j))
#define XB_XSUB(j)  (1280 + 64 * (j))
#define XB_XGEN(j)  (2304 + 64 * (j))
#define XB_TOP      3328
#define XB_TOPGEN   3392
#define XCD_BAR_WORDS 3456
#define XB_SPIN_CAP (1u << 18)

__device__ __forceinline__ unsigned xb_ld(unsigned* p)              { return __hip_atomic_load(p, __ATOMIC_RELAXED, __HIP_MEMORY_SCOPE_AGENT); }
__device__ __forceinline__ unsigned xb_add(unsigned* p, unsigned v) { return __hip_atomic_fetch_add(p, v, __ATOMIC_RELAXED, __HIP_MEMORY_SCOPE_AGENT); }
__device__ __forceinline__ unsigned xb_xcc_id() { return (unsigned)__builtin_amdgcn_s_getreg((3 << 11) | 20) & 0xFu; }
#define XB_SPIN(cond, bar) do { unsigned _sp = 0; while (cond) { __builtin_amdgcn_s_sleep(1); \
    if ((++_sp & 255u) == 0u) { if (xb_ld(&(bar)[XB_TMO])) break; if (_sp > XB_SPIN_CAP) { atomicAdd(&(bar)[XB_TMO], 1u); break; } } } } while (0)

struct XcdBarrier {
    unsigned* bar; unsigned x;
    volatile LAS unsigned* st;
};

__device__ __forceinline__ XcdBarrier xcd_barrier_post(unsigned* bar, volatile LAS unsigned* st) {
    XcdBarrier b; b.bar = bar; b.x = xb_xcc_id(); b.st = st;
    if (threadIdx.x == 0) (void)xb_add(&bar[XB_XCNT(b.x)], 1u);
    return b;
}
__device__ __forceinline__ void xcd_barrier_complete(unsigned* bar, unsigned x, unsigned& nloc, unsigned& nx) {
    const unsigned G = gridDim.x * gridDim.y * gridDim.z;
    unsigned sum, cnt, mine, sp = 0u;
    for (;;) {
        sum = 0u; cnt = 0u; mine = 0u;
#pragma unroll
        for (unsigned j = 0; j < 16; ++j) { const unsigned c = xb_ld(&bar[XB_XCNT(j)]); sum += c; cnt += (c > 0u) ? 1u : 0u; mine = (j == x) ? c : mine; }
        if (sum == G) break;
        __builtin_amdgcn_s_sleep(1);
        if ((++sp & 255u) == 0u) { if (xb_ld(&bar[XB_TMO])) break; if (sp > XB_SPIN_CAP) { atomicAdd(&bar[XB_TMO], 1u); break; } }
    }
    nloc = mine > 0u ? mine : 1u; nx = cnt > 0u ? cnt : 1u;
}

__device__ __forceinline__ void xcd_barrier(const XcdBarrier& b) {
    asm volatile("s_waitcnt vmcnt(0)" ::: "memory");
    __syncthreads();
    if (threadIdx.x == 0) {
        unsigned* bar = b.bar;
        __builtin_amdgcn_s_waitcnt(0);
        unsigned nloc = b.st[0], nx = b.st[1];
        if (nloc == 0u) { xcd_barrier_complete(bar, b.x, nloc, nx); b.st[0] = nloc; b.st[1] = nx; }
        const unsigned old = xb_add(&bar[XB_XSUB(b.x)], 1u);
        const unsigned gen = old / nloc;
        if (old + 1u == (gen + 1u) * nloc) {
            __builtin_amdgcn_fence(__ATOMIC_RELEASE, "agent");
            asm volatile("s_waitcnt vmcnt(0)" ::: "memory");
            const unsigned og = xb_add(&bar[XB_TOP], 1u);
            const unsigned tg = og / nx;
            if (og + 1u == (tg + 1u) * nx) xb_add(&bar[XB_TOPGEN], 1u);
            else XB_SPIN(xb_ld(&bar[XB_TOPGEN]) == tg, bar);
            __builtin_amdgcn_fence(__ATOMIC_ACQUIRE, "agent");
            xb_add(&bar[XB_XGEN(b.x)], 1u);
            asm volatile("s_waitcnt vmcnt(0)" ::: "memory");
        } else {
            XB_SPIN(xb_ld(&bar[XB_XGEN(b.x)]) == gen, bar);
            __builtin_amdgcn_fence(__ATOMIC_ACQUIRE, "agent");
            asm volatile("s_waitcnt vmcnt(0)" ::: "memory");
        }
    }
    __syncthreads();
}


template <int CTRL> __device__ __forceinline__ float dpp_mov(float v) { return __builtin_bit_cast(float, __builtin_amdgcn_mov_dpp(__builtin_bit_cast(int, v), CTRL, 0xf, 0xf, true)); }
__device__ __forceinline__ float wave_sum(float v) {
    v += dpp_mov<0xB1>(v); v += dpp_mov<0x4E>(v); v += dpp_mov<0x141>(v); v += dpp_mov<0x140>(v);
    { auto r = __builtin_amdgcn_permlane16_swap(__float_as_uint(v), __float_as_uint(v), false, false); v = __uint_as_float(r[0]) + __uint_as_float(r[1]); }
    { auto r = __builtin_amdgcn_permlane32_swap(__float_as_uint(v), __float_as_uint(v), false, false); v = __uint_as_float(r[0]) + __uint_as_float(r[1]); }
    return v;
}

__device__ __forceinline__ int dest_row(int n, int mode) { return mode == 0 ? n : ((n >> 7) * 256 + (n & 127) + (mode == 2 ? 128 : 0)); }
__device__ __forceinline__ void p0_tr_item(const float* W, int K, int N, bf16* WT, int item, int mode, const float* kscale, LAS float* scr, int lane, int NC = 0) {
    const int nblk = (NC ? NC : N) >> 6, kb = item / nblk, nb = item - kb * nblk, k0 = kb << 6, n0 = nb << 6;
    const float* src = W + (size_t)k0 * N + n0 + lane;
    if (kscale) { const float ks = kscale[k0 + lane];
#pragma unroll 16
        for (int i = 0; i < 64; ++i) scr[i * 65 + lane] = src[(size_t)i * N] * __builtin_bit_cast(float, __builtin_amdgcn_readlane(__builtin_bit_cast(int, ks), i));
    } else {
#pragma unroll 16
        for (int i = 0; i < 64; ++i) scr[i * 65 + lane] = src[(size_t)i * N];
    }
    LDS_WAIT();
    const int c = lane & 7, drow0 = dest_row(n0, mode);
#pragma unroll
    for (int j = 0; j < 8; ++j) { const int n = (lane >> 3) + 8 * j; const LAS float* s = scr + (8 * c) * 65 + n;
        v4u o; o.x = pk2(s[0 * 65], s[1 * 65]); o.y = pk2(s[2 * 65], s[3 * 65]); o.z = pk2(s[4 * 65], s[5 * 65]); o.w = pk2(s[6 * 65], s[7 * 65]);
        *(v4u*)(WT + (size_t)(drow0 + n) * K + k0 + 8 * c) = o; }
    LDS_WAIT();
}
__device__ __forceinline__ void p0_cmax_item(const float* W, int K, int N, unsigned* cmax, int item, int mode, const float* kscale, int lane, int NC = 0) {
    const int nblk = (NC ? NC : N) >> 8, kb = (item / nblk) * CSUB + (CSUB > 1 ? 1 : 0), nb = item % nblk, k0 = kb << 6, n0 = (nb << 8) + 4 * lane;
    const float* src = W + (size_t)k0 * N + n0;
    f32x4 m = (f32x4){0.f, 0.f, 0.f, 0.f};
    if (kscale) {
        const float ks = fabsf(kscale[k0 + lane]);
#pragma unroll 16
        for (int i = 0; i < 64; ++i) { const f32x4 v = __builtin_nontemporal_load((const f32x4*)(src + (size_t)i * N));
            const float s = __builtin_bit_cast(float, __builtin_amdgcn_readlane(__builtin_bit_cast(int, ks), i)); m = __builtin_elementwise_max(m, __builtin_elementwise_abs(v) * s); }
    } else {
#pragma unroll 16
        for (int i = 0; i < 64; ++i) { const f32x4 v = __builtin_nontemporal_load((const f32x4*)(src + (size_t)i * N)); m = __builtin_elementwise_max(m, __builtin_elementwise_abs(v)); }
    }
    const int d = dest_row(n0, mode);
#pragma unroll
    for (int e = 0; e < 4; ++e) atomicMax(cmax + d + e, __float_as_uint(m[e] * CSAFE));
}
constexpr float Q8_MAGIC = 12582912.0f;
__device__ __forceinline__ unsigned q8pack(float a, float b, float c, float d) {
    const unsigned ua = __float_as_uint(a + Q8_MAGIC), ub = __float_as_uint(b + Q8_MAGIC), uc = __float_as_uint(c + Q8_MAGIC), ud = __float_as_uint(d + Q8_MAGIC);
    const unsigned lo = __builtin_amdgcn_perm(ub, ua, 0x0c0c0400u), hi = __builtin_amdgcn_perm(ud, uc, 0x0c0c0400u);
    return __builtin_amdgcn_perm(hi, lo, 0x05040100u);
}
__device__ __forceinline__ void p0_q8_item(const float* W, int K, int N, signed char* WQ, const unsigned* cmax, int item, int mode, const float* kscale, LAS float* scr, int lane) {
    const int nblk = N >> 6, kb = item / nblk, nb = item - kb * nblk, k0 = kb << 6, n0 = nb << 6;
    const float* src = W + (size_t)k0 * N + n0 + lane;
#pragma unroll 16
    for (int i = 0; i < 64; ++i) { float v = src[(size_t)i * N]; if (kscale) v *= kscale[k0 + i]; scr[i * 65 + lane] = v; }
    LDS_WAIT();
    const int c = lane & 3, drow0 = dest_row(n0, mode);
#pragma unroll
    for (int j = 0; j < 4; ++j) { const int n = (lane >> 2) + 16 * j; const LAS float* s = scr + (16 * c) * 65 + n;
        const float amax = __uint_as_float(cmax[drow0 + n]), inv = amax > 0.f ? 127.0f / amax : 0.f;
        v4u o;
#pragma unroll
        for (int q = 0; q < 4; ++q) o[q] = q8pack(fminf(fmaxf(s[(4 * q + 0) * 65] * inv, -127.f), 127.f), fminf(fmaxf(s[(4 * q + 1) * 65] * inv, -127.f), 127.f), fminf(fmaxf(s[(4 * q + 2) * 65] * inv, -127.f), 127.f), fminf(fmaxf(s[(4 * q + 3) * 65] * inv, -127.f), 127.f));
        *(v4u*)(WQ + (size_t)(drow0 + n) * K + k0 + 16 * c) = o; }
    LDS_WAIT();
}
constexpr int QT_S = 132;
struct Q8P { const float* W; int K, N; signed char* WQ; const unsigned* cmax; int item, mode; const float* kscale; int NC; };
__device__ __forceinline__ void q8_ld(const Q8P q, int wave, int lane, f32x4 (&v)[8], float (&amx)[2], float (&ks)[8]) {
    const int nblk = (q.NC ? q.NC : q.N) >> 7, kb = q.item / nblk, nb = q.item - kb * nblk, k0 = kb << 7, n0 = nb << 7;
    const int r0 = 16 * wave + (lane >> 5), c0 = 4 * (lane & 31);
    const float* src = q.W + (size_t)(k0 + r0) * q.N + n0 + c0;
#pragma unroll
    for (int jj = 0; jj < 2; ++jj) amx[jj] = __uint_as_float(q.cmax[dest_row(n0 + 16 * wave + (lane >> 3) + 8 * jj, q.mode)]);
#pragma unroll
    for (int i = 0; i < 8; ++i) v[i] = __builtin_nontemporal_load((const f32x4*)(src + (size_t)(2 * i) * q.N));
    if (q.kscale) {
#pragma unroll
        for (int i = 0; i < 8; ++i) ks[i] = q.kscale[k0 + r0 + 2 * i]; }
}
__device__ __forceinline__ void q8_to_lds(const Q8P q, const f32x4 (&v)[8], const float (&ks)[8], LAS float* T, int wave, int lane) {
    const int r0 = 16 * wave + (lane >> 5), c0 = 4 * (lane & 31);
    if (q.kscale) {
#pragma unroll
        for (int i = 0; i < 8; ++i) *(LAS f32x4*)(T + (r0 + 2 * i) * QT_S + c0) = v[i] * ks[i]; }
    else {
#pragma unroll
        for (int i = 0; i < 8; ++i) *(LAS f32x4*)(T + (r0 + 2 * i) * QT_S + c0) = v[i]; }
}
__device__ __forceinline__ void q8_quant(const Q8P q, const float (&amx)[2], const LAS float* T, int wave, int lane) {
    const int nblk = (q.NC ? q.NC : q.N) >> 7, kb = q.item / nblk, nb = q.item - kb * nblk, k0 = kb << 7, n0 = nb << 7;
    const int c = lane & 7;
#pragma unroll
    for (int jj = 0; jj < 2; ++jj) { const int n = 16 * wave + (lane >> 3) + 8 * jj, d = dest_row(n0 + n, q.mode); const LAS float* s = T + (16 * c) * QT_S + n;
        const float amax = amx[jj], inv = amax > 0.f ? 127.0f * __builtin_amdgcn_rcpf(amax) : 0.f;
        v4u o;
#pragma unroll
        for (int qq = 0; qq < 4; ++qq) o[qq] = q8pack(fminf(fmaxf(s[(4 * qq + 0) * QT_S] * inv, -127.f), 127.f), fminf(fmaxf(s[(4 * qq + 1) * QT_S] * inv, -127.f), 127.f),
                                                    fminf(fmaxf(s[(4 * qq + 2) * QT_S] * inv, -127.f), 127.f), fminf(fmaxf(s[(4 * qq + 3) * QT_S] * inv, -127.f), 127.f));
        *(v4u*)(q.WQ + (size_t)d * q.K + k0 + 16 * c) = o; }
}
__device__ __forceinline__ void wg_q8_item(const Q8P q, LAS float* T, int wave, int lane) {
    f32x4 v[8]; float amx[2], ks[8];
    q8_ld(q, wave, lane, v, amx, ks); q8_to_lds(q, v, ks, T, wave, lane);
    __syncthreads();
    q8_quant(q, amx, T, wave, lane);
    __syncthreads();
}
__device__ __forceinline__ void wg_q8_item2(const Q8P qa, const Q8P qb, LAS float* T, int wave, int lane) {
    f32x4 va[8], vb[8]; float aa[2], ab[2], ka[8], kb[8];
    q8_ld(qa, wave, lane, va, aa, ka); q8_ld(qb, wave, lane, vb, ab, kb);
    __builtin_amdgcn_sched_barrier(0);
    q8_to_lds(qa, va, ka, T, wave, lane); q8_to_lds(qb, vb, kb, T + 128 * QT_S, wave, lane);
    __syncthreads();
    q8_quant(qa, aa, T, wave, lane); q8_quant(qb, ab, T + 128 * QT_S, wave, lane);
    __syncthreads();
}
static_assert(2 * 128 * QT_S * 4 <= LDSCTL_OFF, "two weight-copy tiles in LDS");
__device__ __forceinline__ void p0_gemv_item(const float* cvec, const float* Wada, float* modp, int item, LAS float* scr, int lane) {
    const int cc = item % (NMODV / 256), ks = item / (NMODV / 256), k0 = ks * 256, col = cc * 256 + 4 * lane;
#pragma unroll
    for (int b = 0; b < 4; ++b) { f32x4 v = *(const f32x4*)(cvec + b * D + k0 + 4 * lane);
#pragma unroll
        for (int e = 0; e < 4; ++e) v[e] = v[e] / (1.0f + __expf(-v[e]));
        *(LAS f32x4*)(scr + b * 256 + 4 * lane) = v; }
    LDS_WAIT();
    f32x4 acc[4];
#pragma unroll
    for (int b = 0; b < 4; ++b) acc[b] = (f32x4){0.f, 0.f, 0.f, 0.f};
    const float* wp = Wada + (size_t)k0 * NMODV + col;
#pragma unroll 2
    for (int k4 = 0; k4 < 64; ++k4) {
        const f32x4 w0 = __builtin_nontemporal_load((const f32x4*)(wp + (size_t)(4 * k4 + 0) * NMODV)), w1 = __builtin_nontemporal_load((const f32x4*)(wp + (size_t)(4 * k4 + 1) * NMODV));
        const f32x4 w2 = __builtin_nontemporal_load((const f32x4*)(wp + (size_t)(4 * k4 + 2) * NMODV)), w3 = __builtin_nontemporal_load((const f32x4*)(wp + (size_t)(4 * k4 + 3) * NMODV));
#pragma unroll
        for (int b = 0; b < 4; ++b) { const f32x4 s = *(const LAS f32x4*)(scr + b * 256 + 4 * k4);
            acc[b] += s[0] * w0; acc[b] += s[1] * w1; acc[b] += s[2] * w2; acc[b] += s[3] * w3; }
    }
#pragma unroll
    for (int b = 0; b < 4; ++b) *(f32x4*)(modp + ((size_t)(ks * 4 + b)) * NMODV + col) = acc[b];
    LDS_WAIT();
}
__device__ __forceinline__ float mod_reduce(const float* modp, const float* bada, int b, int j) {
    float s = bada[j];
#pragma unroll
    for (int ks = 0; ks < KS_ADA; ++ks) s += modp[((size_t)(ks * 4 + b)) * NMODV + j];
    return s;
}

__device__ __forceinline__ float wave_max(float v) {
    v = fmaxf(v, dpp_mov<0xB1>(v)); v = fmaxf(v, dpp_mov<0x4E>(v)); v = fmaxf(v, dpp_mov<0x141>(v)); v = fmaxf(v, dpp_mov<0x140>(v));
    { auto r = __builtin_amdgcn_permlane16_swap(__float_as_uint(v), __float_as_uint(v), false, false); v = fmaxf(__uint_as_float(r[0]), __uint_as_float(r[1])); }
    { auto r = __builtin_amdgcn_permlane32_swap(__float_as_uint(v), __float_as_uint(v), false, false); v = fmaxf(__uint_as_float(r[0]), __uint_as_float(r[1])); }
    return v;
}
template <int HQ>
__device__ __forceinline__ void store_h(const f32x4 (&v)[16], float rstd, void* hrow, float* rscale, const LAS float* vA, const LAS float* vS, int lane) {
    if (HQ == 0) { GAS v2u* o8 = (GAS v2u*)hrow + lane;
#pragma unroll
        for (int jb = 0; jb < 16; jb += 4) { f32x4 a[4], s[4];
#pragma unroll
            for (int jj = 0; jj < 4; ++jj) { a[jj] = *(const LAS f32x4*)(vA + 256 * (jb + jj) + 4 * lane); s[jj] = *(const LAS f32x4*)(vS + 256 * (jb + jj) + 4 * lane); }
#pragma unroll
            for (int jj = 0; jj < 4; ++jj) { const f32x4 h = v[jb + jj] * rstd * a[jj] + s[jj]; o8[64 * (jb + jj)] = (v2u){pk2(h.x, h.y), pk2(h.z, h.w)}; } } }
    else { float am = 0.f;
#pragma unroll
        for (int jb = 0; jb < 16; jb += 4) { f32x4 a[4], s[4];
#pragma unroll
            for (int jj = 0; jj < 4; ++jj) { a[jj] = *(const LAS f32x4*)(vA + 256 * (jb + jj) + 4 * lane); s[jj] = *(const LAS f32x4*)(vS + 256 * (jb + jj) + 4 * lane); }
#pragma unroll
            for (int jj = 0; jj < 4; ++jj) { const f32x4 h = __builtin_elementwise_abs(v[jb + jj] * rstd * a[jj] + s[jj]); am = fmaxf(am, fmaxf(fmaxf(h.x, h.y), fmaxf(h.z, h.w))); } }
        am = wave_max(am); const float inv = am > 0.f ? 127.0f / am : 0.f;
        asm volatile("" ::: "memory");
        if (lane == 0) *(GAS float*)rscale = am * (1.0f / 127.0f);
        GAS unsigned* o4 = (GAS unsigned*)hrow + lane;
#pragma unroll
        for (int jb = 0; jb < 16; jb += 4) { f32x4 a[4], s[4];
#pragma unroll
            for (int jj = 0; jj < 4; ++jj) { a[jj] = *(const LAS f32x4*)(vA + 256 * (jb + jj) + 4 * lane); s[jj] = *(const LAS f32x4*)(vS + 256 * (jb + jj) + 4 * lane); }
#pragma unroll
            for (int jj = 0; jj < 4; ++jj) { const f32x4 h = (v[jb + jj] * rstd * a[jj] + s[jj]) * inv; o4[64 * (jb + jj)] = q8pack(h.x, h.y, h.z, h.w); } } }
}
template <int HQ>
__device__ __forceinline__ void row_norm_mod(const float* xrow, void* hrow, float* rscale, const LAS float* vA, const LAS float* vS, int lane) {
    const f32x4* xr = (const f32x4*)xrow + lane; f32x4 v[16]; float ss = 0.f;
#pragma unroll
    for (int j = 0; j < 16; ++j) { v[j] = __builtin_nontemporal_load(xr + 64 * j); ss += (v[j].x * v[j].x + v[j].y * v[j].y) + (v[j].z * v[j].z + v[j].w * v[j].w); }
    const float rstd = 1.0f / sqrtf(wave_sum(ss) * (1.0f / D) + EPS);
    store_h<HQ>(v, rstd, hrow, rscale, vA, vS, lane);
}
template <bool NEXT, int HQ, int XS, int OS, int HQ2 = -1>
__device__ __forceinline__ void row_resid(const void* xrow, const unsigned char* yrow, const float* yscr, void* orow, void* hrow, void* hrow2, float* rscale, const LAS float* vG, const LAS float* vA, const LAS float* vS, int lane) {
    const unsigned* y4 = (const unsigned*)yrow + lane; const float* ysr = yscr + (lane >> 3);
    unsigned yq[16]; float ysv[16]; float ss = 0.f;
#pragma unroll
    for (int j = 0; j < 16; ++j) { yq[j] = __builtin_nontemporal_load(y4 + 64 * j); ysv[j] = __builtin_nontemporal_load(ysr + 8 * j); }
    f32x4 xv[XS == 0 ? 16 : 1]; v2u xw[XS == 0 ? 1 : 16];
    if (XS == 0) { const f32x4* xr = (const f32x4*)xrow + lane;
#pragma unroll
        for (int j = 0; j < 16; ++j) xv[j] = __builtin_nontemporal_load(xr + 64 * j); }
    else { const v2u* xr = (const v2u*)xrow + lane;
#pragma unroll
        for (int j = 0; j < 16; ++j) xw[j] = __builtin_nontemporal_load(xr + 64 * j); }
    __builtin_amdgcn_sched_barrier(0);
#pragma unroll
    for (int j = 0; j < 16; ++j) { const float s = ysv[j], o = -128.0f * s; const float a = fmaf((float)(yq[j] & 0xffu), s, o), b = fmaf((float)((yq[j] >> 8) & 0xffu), s, o), c = fmaf((float)((yq[j] >> 16) & 0xffu), s, o), d = fmaf((float)(yq[j] >> 24), s, o); ss += (a * a + b * b) + (c * c + d * d); }
    const float rstd_y = 1.0f / sqrtf(wave_sum(ss) * (1.0f / D) + EPS);
    asm volatile("" ::: "memory");
    f32x4 v[NEXT ? 16 : 1]; float ss1 = 0.f;
#pragma unroll
    for (int jb = 0; jb < 16; jb += 4) { f32x4 g4[4];
#pragma unroll
        for (int jj = 0; jj < 4; ++jj) g4[jj] = *(const LAS f32x4*)(vG + 256 * (jb + jj) + 4 * lane);
#pragma unroll
        for (int jj = 0; jj < 4; ++jj) { const int j = jb + jj; const f32x4 g = g4[jj];
            const float ys_ = ysv[j], yo_ = -128.0f * ys_;
            const f32x4 y = (f32x4){fmaf((float)(yq[j] & 0xffu), ys_, yo_), fmaf((float)((yq[j] >> 8) & 0xffu), ys_, yo_), fmaf((float)((yq[j] >> 16) & 0xffu), ys_, yo_), fmaf((float)(yq[j] >> 24), ys_, yo_)};
            const f32x4 x = XS == 0 ? xv[XS == 0 ? j : 0] : (f32x4){bf_lo(xw[XS == 0 ? 0 : j].x), bf_hi(xw[XS == 0 ? 0 : j].x), bf_lo(xw[XS == 0 ? 0 : j].y), bf_hi(xw[XS == 0 ? 0 : j].y)};
            f32x4 r = x + g * (y * rstd_y);
            if (OS == 0) ((GAS f32x4*)orow + lane)[64 * j] = r;
            else { const v2u w = (v2u){pk2(r.x, r.y), pk2(r.z, r.w)}; ((GAS v2u*)orow + lane)[64 * j] = w;
                   r = (f32x4){bf_lo(w.x), bf_hi(w.x), bf_lo(w.y), bf_hi(w.y)}; }
            if (NEXT) { v[NEXT ? j : 0] = r; ss1 += (r.x * r.x + r.y * r.y) + (r.z * r.z + r.w * r.w); } } }
    if (NEXT) { const float rstd = 1.0f / sqrtf(wave_sum(ss1) * (1.0f / D) + EPS); store_h<HQ>((const f32x4 (&)[16])v, rstd, hrow, rscale, vA, vS, lane);
        if (HQ2 >= 0) { asm volatile("" ::: "memory"); store_h<(HQ2 >= 0 ? HQ2 : 0)>((const f32x4 (&)[16])v, rstd, hrow2, rscale, vA, vS, lane); } }
}
template <int HQ>
__device__ __forceinline__ void row_groupnorm(const bf16* orow, void* hrow, float* rscale, int lane) {
    const v4u* o16 = (const v4u*)orow + lane; v4u w[8]; float sa = 0.f, sb = 0.f;
#pragma unroll
    for (int j = 0; j < 8; ++j) { w[j] = __builtin_nontemporal_load(o16 + 64 * j); float s = 0.f;
#pragma unroll
        for (int e = 0; e < 4; ++e) { const float a = bf_lo(w[j][e]), c = bf_hi(w[j][e]); s += a * a + c * c; }
        if (j < 4) sa += s; else sb += s; }
    const float ra = 1.0f / sqrtf(wave_sum(sa) * (1.0f / 2048.f) + EPS), rb = 1.0f / sqrtf(wave_sum(sb) * (1.0f / 2048.f) + EPS);
    if (HQ == 0) { v4u* h16 = (v4u*)hrow + lane;
#pragma unroll
        for (int j = 0; j < 8; ++j) { const float r = j < 4 ? ra : rb; v4u o;
#pragma unroll
            for (int e = 0; e < 4; ++e) o[e] = pk2(bf_lo(w[j][e]) * r, bf_hi(w[j][e]) * r);
            h16[64 * j] = o; } }
    else { float am = 0.f;
#pragma unroll
        for (int j = 0; j < 8; ++j) { const float r = j < 4 ? ra : rb;
#pragma unroll
            for (int e = 0; e < 4; ++e) am = fmaxf(am, fmaxf(fabsf(bf_lo(w[j][e]) * r), fabsf(bf_hi(w[j][e]) * r))); }
        am = wave_max(am); const float inv = am > 0.f ? 127.0f / am : 0.f;
        if (lane == 0) *rscale = am * (1.0f / 127.0f);
        v2u* h8 = (v2u*)hrow + lane;
#pragma unroll
        for (int j = 0; j < 8; ++j) { const float r = (j < 4 ? ra : rb) * inv;
            h8[64 * j] = (v2u){q8pack(bf_lo(w[j][0]) * r, bf_hi(w[j][0]) * r, bf_lo(w[j][1]) * r, bf_hi(w[j][1]) * r), q8pack(bf_lo(w[j][2]) * r, bf_hi(w[j][2]) * r, bf_lo(w[j][3]) * r, bf_hi(w[j][3]) * r)}; } }
}
constexpr int NLS = FF / 32;
__device__ __forceinline__ void row_actq(signed char* qrow, const float* lrow, const unsigned* rowmax, float* rsa, int lane) {
    v4u* q16 = (v4u*)qrow; v4u w[11]; float f[11];
#pragma unroll
    for (int j = 0; j < 11; ++j) { const int idx = j * 64 + lane; const bool on = j < 10 || lane < 48;
        w[j] = on ? __builtin_nontemporal_load(q16 + idx) : (v4u){0u, 0u, 0u, 0u}; f[j] = on ? __builtin_nontemporal_load(lrow + (idx >> 1)) : 0.f; }
    const float amax = __uint_as_float(*rowmax), inv = amax > 0.f ? 127.0f / amax : 0.f;
    if (lane == 0) *rsa = amax * (1.0f / 127.0f);
#pragma unroll
    for (int j = 0; j < 11; ++j) { const int idx = j * 64 + lane; const float s = f[j] * inv;
        v4u o;
#pragma unroll
        for (int e = 0; e < 4; ++e) { const unsigned x = w[j][e]; const float o128 = -128.0f * s;
            const float a = fmaf((float)(x & 0xffu), s, o128), b = fmaf((float)((x >> 8) & 0xffu), s, o128), c = fmaf((float)((x >> 16) & 0xffu), s, o128), d = fmaf((float)(x >> 24), s, o128);
            o[e] = q8pack(a, b, c, d); }
        if (j < 10 || lane < 48) q16[idx] = o; }
}
static_assert(FF / 16 == 10 * 64 + 48 && FF % 32 == 0, "row_actq chunking");
#define P0_PARAMS const float* P_c_in, const float* P_w_ada, const float* P_f1_wg, const float* P_f1_wu, const float* P_f1_wd, const float* P_w_in, const float* P_w_out, const float* P_norm_a, const float* P_norm_b, \
        const float* P_f2_wg, const float* P_f2_wu, const float* P_f2_wd, float* P_modp, unsigned char* P_Wgu1, unsigned char* P_Wd1, unsigned char* P_Win, unsigned char* P_Wout, unsigned char* P_Wgu2, unsigned char* P_Wd2, unsigned* P_cmax1, unsigned* P_cmax2, unsigned* P_cmaxo
#define P0_ARGS P_c_in, P_w_ada, P_f1_wg, P_f1_wu, P_f1_wd, P_w_in, P_w_out, P_norm_a, P_norm_b, P_f2_wg, P_f2_wu, P_f2_wd, P_modp, P_Wgu1, P_Wd1, P_Win, P_Wout, P_Wgu2, P_Wd2, P_cmax1, P_cmax2, P_cmaxo
__device__ __forceinline__ void p0_phase(LAS unsigned char* lds, int wave, int lane, int blk, int G, P0_PARAMS) {
    LAS float* scr = (LAS float*)(lds + wave * WAVE_SCR);
    const int gw = blk * NWAVES + wave, NGW = G * NWAVES;
    constexpr int I_T = (D / 64) * (FF / 64)  , I_C = (D / 64 / CSUB) * (FF / 256)  ;
    constexpr int I_1 = F1Q ? I_C : I_T, I_2 = F2Q ? I_C : I_T, I_IN = (D / 64) * (NBF / 64)  , I_CI = (D / 64 / CSUB) * NT8  , I_OUT = WOQ ? (D / 64 / CSUB) * (D / 256) : (D / 64) * (D / 64), I_GV = (NMODV / 256) * KS_ADA;
    constexpr int NITEMS = I_GV + 3 * I_1 + I_IN + I_CI + I_OUT + 3 * I_2;
    static_assert((FF / 64) * (D / 64) == I_T && (FF / 64 / CSUB) * (D / 256) == I_C, "item counts (the down matrix has K = FF, N = D)");
    for (int it = gw; it < NITEMS; it += NGW) {
        int r = it;
        if (r < I_GV) { p0_gemv_item(P_c_in, P_w_ada, P_modp, r, scr, lane); continue; } r -= I_GV;
        if (r < 3 * I_1) { const int w = r / I_1; r -= w * I_1;
            const float* src = w == 0 ? P_f1_wg : (w == 1 ? P_f1_wu : P_f1_wd);
            if (F1Q) p0_cmax_item(src, w == 2 ? FF : D, w == 2 ? D : FF, P_cmax1 + (w == 2 ? CMAX_DN : 0), r, w == 2 ? 0 : w + 1, nullptr, lane);
            else p0_tr_item(src, w == 2 ? FF : D, w == 2 ? D : FF, (bf16*)(w == 2 ? P_Wd1 : P_Wgu1), r, w == 2 ? 0 : w + 1, nullptr, scr, lane);
            continue; } r -= 3 * I_1;
        if (r < I_IN) { const int gt = r / ((D / 64) * 4), sub = r - gt * ((D / 64) * 4);
            p0_tr_item(P_w_in + 256 * pg8::nth_set(BFMASK, gt), D, DIN, (bf16*)P_Win + (size_t)gt * 256 * D, sub, 0, nullptr, scr, lane, 256); continue; } r -= I_IN;
        if (r < I_CI) { const int gt = r / (D / 64 / CSUB), sub = r - gt * (D / 64 / CSUB);
            p0_cmax_item(P_w_in + 256 * pg8::nth_set(I8MASK, gt), D, DIN, P_cmaxo + (CW_CMAXI - CW_CMAXO) + 256 * gt, sub, 0, nullptr, lane, 256); continue; } r -= I_CI;
        if (r < I_OUT) { if (WOQ) { const int kb = (r / (D / 256)) * CSUB; p0_cmax_item(P_w_out, D, D, P_cmaxo, r, 0, (kb < 32 ? P_norm_a : P_norm_b - 2048), lane); }
            else { const int kb = r / (D / 64); p0_tr_item(P_w_out, D, D, (bf16*)P_Wout, r, 0, (kb < 32 ? P_norm_a : P_norm_b - 2048), scr, lane); } continue; } r -= I_OUT;
        { const int w = r / I_2; r -= w * I_2;
            const float* src = w == 0 ? P_f2_wg : (w == 1 ? P_f2_wu : P_f2_wd);
            if (F2Q) p0_cmax_item(src, w == 2 ? FF : D, w == 2 ? D : FF, P_cmax2 + (w == 2 ? CMAX_DN : 0), r, w == 2 ? 0 : w + 1, nullptr, lane);
            else p0_tr_item(src, w == 2 ? FF : D, w == 2 ? D : FF, (bf16*)(w == 2 ? P_Wd2 : P_Wgu2), r, w == 2 ? 0 : w + 1, nullptr, scr, lane); }
    }
}
constexpr int I_W = (D / 128) * (FF / 128);
static_assert((FF / 128) * (D / 128) == I_W, "item counts (the down matrix has K = FF, N = D)");
constexpr int POOL_N = 3 * I_W + (D / 128) * (D / 128);
__device__ __forceinline__ Q8P pool_q8p(int p, P0_PARAMS) {
    if (p < 3 * I_W) { const int w = p / I_W, r = p - w * I_W;
        return Q8P{w == 0 ? P_f2_wg : (w == 1 ? P_f2_wu : P_f2_wd), w == 2 ? FF : D, w == 2 ? D : FF, (signed char*)(w == 2 ? P_Wd2 : P_Wgu2), P_cmax2 + (w == 2 ? CMAX_DN : 0), r, w == 2 ? 0 : w + 1, nullptr}; }
    const int r = p - 3 * I_W, kb = r / (D / 128);
    return Q8P{P_w_out, D, D, (signed char*)P_Wout, P_cmaxo, r, 0, (kb < 16 ? P_norm_a : P_norm_b - 2048)};
}
__device__ __forceinline__ void pool_fill(LAS unsigned char* lds, int wave, int lane, int blk, int G, int first, int base, int per_wg, P0_PARAMS) {
    if (blk < first) return;
    const int nq = G - first, wq = blk - first;
    for (int i = 0; i < per_wg; i += 2) { const int p = base + i * nq + wq, p2 = p + nq;
        if (p >= POOL_N) break;
        if (i + 1 < per_wg && p2 < POOL_N) wg_q8_item2(pool_q8p(p, P0_ARGS), pool_q8p(p2, P0_ARGS), (LAS float*)lds, wave, lane);
        else wg_q8_item(pool_q8p(p, P0_ARGS), (LAS float*)lds, wave, lane); }
}
constexpr int I_WIN = (D / 128) * (NI8 / 128);
constexpr size_t WINA_OFF = (size_t)NBF * D * 2;
constexpr int POOL_C0 = 2 * I_W;
__device__ __forceinline__ Q8P p1_q8p(int it, int fill_n, int rest1, int c_n, P0_PARAMS) {
    if (it >= 3 * I_W && it < 3 * I_W + I_WIN) { const int j = it - 3 * I_W; unsigned* cmi = P_cmaxo + (CW_CMAXI - CW_CMAXO);
        const int gt = j / ((D / 128) * 2), sub = j - gt * ((D / 128) * 2);
        return Q8P{P_w_in + 256 * pg8::nth_set(I8MASK, gt), D, DIN, (signed char*)(P_Win + WINA_OFF) + (size_t)gt * 256 * D, cmi + 256 * gt, sub, 0, nullptr, 256}; }
    if (it >= 3 * I_W + I_WIN) it -= I_WIN;
    if (it < 3 * I_W) { const int w = it / I_W, r = it - w * I_W;
        return Q8P{w == 0 ? P_f1_wg : (w == 1 ? P_f1_wu : P_f1_wd), w == 2 ? FF : D, w == 2 ? D : FF, (signed char*)(w == 2 ? P_Wd1 : P_Wgu1), P_cmax1 + (w == 2 ? CMAX_DN : 0), r, w == 2 ? 0 : w + 1, nullptr}; }
    const int j = it - 3 * I_W;
    return pool_q8p(j < rest1 ? fill_n + j : POOL_C0 + c_n + (j - rest1), P0_ARGS);
}
template <int HQ>
__device__ __forceinline__ void p1_phase(LAS unsigned char* lds, int tid, int wave, int lane, int blk, int G, P0_PARAMS, const float* x_in, const float* b_ada, const float* f1_pre, float* modf, void* Hb, float* rsh) {
    static_assert(F1Q && F2Q && WOQ, "the pool split below is written for the all-int8 configuration");
    {
        const int rem_a = ((M / 256) * (2 * FF / 256)) % G, rem_b = ((M / 256) * (NI8 / 256)) % G;
        const int short_wgs = rem_a ? G - rem_a : 0, short_wgs_b = rem_b ? G - rem_b : 0;
        const int fill_n = FILLA * short_wgs + FILLB * short_wgs_b;
        const bool c_ok = fill_n <= POOL_C0 && FILLC * short_wgs <= I_W;
        const int c_n = c_ok ? FILLC * short_wgs : 0, rest1 = c_ok ? POOL_C0 - fill_n : (POOL_N > fill_n ? POOL_N - fill_n : 0), rest2 = c_ok ? POOL_N - (POOL_C0 + c_n) : 0;
        const int NQ = 3 * I_W + I_WIN + rest1 + rest2;
        for (int it = blk; it < NQ; it += 2 * G) { const int it2 = it + G;
            if (it2 < NQ) wg_q8_item2(p1_q8p(it, fill_n, rest1, c_n, P0_ARGS), p1_q8p(it2, fill_n, rest1, c_n, P0_ARGS), (LAS float*)lds, wave, lane);
            else wg_q8_item(p1_q8p(it, fill_n, rest1, c_n, P0_ARGS), (LAS float*)lds, wave, lane);
        }
    }
    const float* modp = P_modp;
    for (int j = blk * (NWAVES * 64) + tid; j < 4 * NMODV; j += G * NWAVES * 64) { const int b = j / NMODV, jj = j - b * NMODV; modf[j] = mod_reduce(modp, b_ada, b, jj); }
    LAS float* vA = (LAS float*)lds; LAS float* vS = vA + D;
    int cur_b = -1;
    for (int ch = blk; ch < M / 64; ch += G) {
        const int b = ch / (SEQ / 64);
        if (b != cur_b) { __syncthreads();
            for (int k = tid; k < D; k += NWAVES * 64) { vA[k] = f1_pre[k] * (1.0f + mod_reduce(modp, b_ada, b, 1 * D + k)); vS[k] = mod_reduce(modp, b_ada, b, 0 * D + k); }
            __syncthreads(); cur_b = b; }
#pragma unroll 1
        for (int i = 0; i < 8; ++i) { const size_t row = (size_t)ch * 64 + wave * 8 + i; row_norm_mod<HQ>(x_in + row * D, (unsigned char*)Hb + row * D * (HQ ? 1 : 2), rsh + row, vA, vS, lane); }
    }
    __syncthreads();
}
__device__ __forceinline__ void p6_phase(LAS unsigned char* lds, int tid, int blk, int G, const bf16* PROJ, float* kmean) {
    LAS float* red = (LAS float*)lds;
    for (int it = blk; it < 256; it += G) {
        const int b = it >> 6, kvh = (it >> 4) & 3, kb = it & 15;
        const int c8 = tid & 15, rg = tid >> 4;
        const bf16* src = PROJ + ((size_t)b * SEQ + kb * 256 + rg) * DIN + 4608 + kvh * 128 + c8 * 8;
        float s[8];
#pragma unroll
        for (int e = 0; e < 8; ++e) s[e] = 0.f;
#pragma unroll
        for (int i = 0; i < 8; ++i) { const v4u w = *(const v4u*)(src + (size_t)(32 * i) * DIN);
#pragma unroll
            for (int e = 0; e < 4; ++e) { s[2 * e] += bf_lo(w[e]); s[2 * e + 1] += bf_hi(w[e]); } }
#pragma unroll
        for (int e = 0; e < 8; ++e) red[rg * 128 + c8 * 8 + e] = s[e];
        __syncthreads();
        if (tid < 128) { float t = 0.f;
#pragma unroll
            for (int r = 0; r < 32; ++r) t += red[r * 128 + tid];
            kmean[(size_t)it * 128 + tid] = t * (1.0f / 256.f); }
        __syncthreads();
    }
}
template <int VAR = 0> __device__ __forceinline__ void p7_phase(LAS unsigned char* lds, int blk, int G, const bf16* PROJ, bf16* Ob, const float* kmean, const float* sinks) {
    for (int it = blk; it < 512 + 1024; it += G) {
        if (it < 512) { const int xcd = it & 7, k = it >> 3, bk = xcd + 8 * (k >> 5), xq = k & 31;
#pragma unroll 1
            for (int h = 0; h < 2; ++h) att::attn_unit<1, VAR>(lds, PROJ, Ob, kmean, sinks, bk >> 2, bk & 3, (h ? 63 - xq : xq) * 64); }
        else { const int u = it - 512, bk = u & 7, tqi = u >> 3;
            att::attn_unit<0, VAR>(lds, PROJ, Ob, kmean, sinks, bk >> 1, bk & 1, tqi * 32); }
    }
}

struct Args { const float* in[21]; float* out; unsigned char* ws; int ph_lo, ph_hi, pk, pad; };
static_assert(sizeof(Args) == 200, "Args has no padding bytes");

__global__ void __launch_bounds__(NWAVES * 64, 2) mk_fwd(Args args) {
    extern __shared__ __attribute__((aligned(16))) unsigned char lds_raw[];
    LAS unsigned char* lds = (LAS unsigned char*)lds_raw;
    volatile LAS unsigned* MISC = (volatile LAS unsigned*)(lds + LDSCTL_OFF);
    const int tid = threadIdx.x, lane = tid & 63, wave = __builtin_amdgcn_readfirstlane(tid >> 6);
    const int G = gridDim.x, blk = blockIdx.x;
    unsigned char* ws = args.ws;
    unsigned* ctl = (unsigned*)(ws + WS_CTL);
    const float* x_in = args.in[0]; const float* b_ada = args.in[3];
    const float* f1_pre = args.in[4]; const float* f1_post = args.in[5];
    const float* mx_pre = args.in[9]; const float* mx_post = args.in[10]; const float* sinks = args.in[12];
    const float* f2_pre = args.in[16]; const float* f2_post = args.in[17];
    float* out = args.out;
    float* modf = (float*)(ws + WS_MOD); float* kmean = (float*)(ws + WS_KMEAN); float* rsh = (float*)(ws + WS_RSH); float* rsa = (float*)(ws + WS_RSA);
    const float* P_c_in = args.in[1]; const float* P_w_ada = args.in[2]; const float* P_f1_wg = args.in[6]; const float* P_f1_wu = args.in[7]; const float* P_f1_wd = args.in[8]; const float* P_w_in = args.in[11]; const float* P_w_out = args.in[15];
    const float* P_norm_a = args.in[13]; const float* P_norm_b = args.in[14]; const float* P_f2_wg = args.in[18]; const float* P_f2_wu = args.in[19]; const float* P_f2_wd = args.in[20]; float* P_modp = (float*)(ws + WS_MODP);
    unsigned char* P_Wgu1 = ws + WS_WGU1; unsigned char* P_Wd1 = ws + WS_WD1; unsigned char* P_Win = ws + WS_WIN; unsigned char* P_Wout = ws + WS_WOUT; unsigned char* P_Wgu2 = ws + WS_WGU2; unsigned char* P_Wd2 = ws + WS_WD2; unsigned* P_cmax1 = ctl + CW_CMAX1; unsigned* P_cmax2 = ctl + CW_CMAX2; unsigned* P_cmaxo = ctl + CW_CMAXO;
    bf16* Hb = (bf16*)(ws + WS_H); bf16* ACT = (bf16*)(ws + WS_ACT); bf16* Yb = (bf16*)(ws + WS_Y); unsigned char* Y8 = ws + WS_Y; float* YSC = (float*)(ws + WS_Y + (size_t)M * D); bf16* PROJ = (bf16*)(ws + WS_PROJ); bf16* Ob = (bf16*)(ws + WS_O);
    signed char* ACT8 = (signed char*)(ws + WS_ACT8); bf16* XR = (bf16*)(ws + WS_XR); float* LSC = (float*)(ws + WS_ACT);

    for (int u = tid; u < (LDS_BYTES - LDSCTL_OFF) / 4; u += NWAVES * 64) ((LAS unsigned*)(lds + LDSCTL_OFF))[u] = 0u;
    __syncthreads();
    XcdBarrier bar; bar.bar = ctl + CW_BAR; bar.x = 0; bar.st = nullptr;
    if (N_LAUNCHES == 1) bar = xcd_barrier_post(ctl + CW_BAR, MISC + 8);
    const int lo = args.ph_lo, hi = args.ph_hi;
#define IN(k) (lo <= (k) && (k) < hi)
#define SEAM(k) do { if (IN(k) && IN((k) + 1)) xcd_barrier(bar); } while (0)

#define PH0() p0_phase(lds, wave, lane, blk, G, P0_ARGS)
#define PH1() p1_phase<F1Q ? 1 : 0>(lds, tid, wave, lane, blk, G, P0_ARGS, x_in, b_ada, f1_pre, modf, Hb, rsh)
#define GEMM_GU(Wt) do { pg8::Gemm g{Hb, (const bf16*)(Wt), M, 2 * FF, D}; pg8::StaticOrder S; S.init(M, 2 * FF, G, blk); pg8::EpiSwiGLU E{ACT, FF}; \
        pg8::gemm_phase<pg8::EpiSwiGLU, pg8::StaticOrder, true, true, 0>(lds, g, S, E); } while (0)
#define GEMM_GU_I8(Wt, CM, RM) do { pg8::Gemm g{Hb, (const bf16*)(Wt), M, 2 * FF, D / 2}; pg8::StaticOrder S; S.init(M, 2 * FF, G, blk); pg8::EpiSwiGLUQ E{ACT8, FF, LSC, NLS, rsh, CM, RM}; \
        pg8::gemm_phase<pg8::EpiSwiGLUQ, pg8::StaticOrder, true, true, 1>(lds, g, S, E); } while (0)
#define GEMM_BF(Aop, Wt, Nn, Kk, Out) do { pg8::Gemm g{Aop, (const bf16*)(Wt), M, Nn, Kk}; pg8::StaticOrder S; S.init(M, Nn, G, blk); pg8::EpiBf16P E{Out, Nn, 0u}; \
        pg8::gemm_phase<pg8::EpiBf16P, pg8::StaticOrder, true, true, 0>(lds, g, S, E); } while (0)
#define GEMM_DN_I8(Wt, CM) do { pg8::Gemm g{(const bf16*)ACT8, (const bf16*)(Wt), M, D, FF / 2}; pg8::StaticOrder S; S.init(M, D, G, blk); pg8::EpiQ8Y E{Y8, D, YSC, rsa, (CM) + CMAX_DN}; \
        pg8::gemm_phase<pg8::EpiQ8Y, pg8::StaticOrder, true, true, 1>(lds, g, S, E); } while (0)
#define ACTQ(RM) do { for (int row = blk * NWAVES + wave; row < M; row += G * NWAVES) row_actq(ACT8 + (size_t)row * FF, LSC + (size_t)row * NLS, (RM) + row, rsa + row, lane); } while (0)
#define RESID(NEXT, HQ, XS, OS, SRC, DST, I, RESW, GPOST, GPRE_NEXT, HQ2, HB2) do { \
        LAS float* vG = (LAS float*)lds; LAS float* vA = vG + D; LAS float* vS = vA + D; int cur_b = -1; \
        for (int ch = blk; ch < M / 64; ch += G) { const int b = ch / (SEQ / 64); \
            if (b != cur_b) { __syncthreads(); const float* mb = modf + (size_t)b * NMODV; \
                for (int k = tid; k < D; k += NWAVES * 64) { vG[k] = (RESW) * mb[(3 * (I) + 2) * D + k] * (GPOST)[k]; \
                    if (NEXT) { vA[k] = (GPRE_NEXT)[k] * (1.0f + mb[(3 * (I) + 4) * D + k]); vS[k] = mb[(3 * (I) + 3) * D + k]; } } \
                __syncthreads(); cur_b = b; } \
            _Pragma("unroll 1") for (int i = 0; i < 8; ++i) { const size_t row = (size_t)ch * 64 + wave * 8 + i; \
                row_resid<NEXT, HQ, XS, OS, HQ2>((const unsigned char*)(SRC) + row * D * ((XS) ? 2 : 4), Y8 + row * D, YSC + row * (D / 32), (unsigned char*)(DST) + row * D * ((OS) ? 2 : 4), (unsigned char*)Hb + row * D * ((HQ) ? 1 : 2), (unsigned char*)(HB2) + row * D * ((HQ2) == 1 ? 1 : 2), rsh + row, vG, vA, vS, lane); } } \
        __syncthreads(); } while (0)
#define PH2() do { if (F1Q) GEMM_GU_I8(P_Wgu1, P_cmax1, ctl + CW_ROWMAX1); else GEMM_GU(P_Wgu1); \
        { const int nsh_ = ((M / 256) * (2 * FF / 256)) % G; if (nsh_) pool_fill(lds, wave, lane, blk, G, nsh_, 0, FILLA, P0_ARGS); } } while (0)
#define PH3() ACTQ(ctl + CW_ROWMAX1)
#define PH4() do { if (F1Q) GEMM_DN_I8(P_Wd1, P_cmax1); else GEMM_BF(ACT, P_Wd1, D, FF, Yb); } while (0)
#define PH5() RESID(true, 0, 0, 1, x_in, XR, 0, 0.5f, f1_post, mx_pre, 1, ACT8)
#define GEMM_IN_I8() do { pg8::Gemm g{(const bf16*)ACT8, (const bf16*)(P_Win + WINA_OFF), M, NI8, D / 2}; pg8::StaticOrder S; S.init(M, NI8, G, blk); pg8::EpiBf16I8 E{PROJ, DIN, rsh, P_cmaxo + (CW_CMAXI - CW_CMAXO), I8MASK}; \
        pg8::gemm_phase<pg8::EpiBf16I8, pg8::StaticOrder, true, true, 1>(lds, g, S, E); } while (0)
#define GEMM_IN_BF() do { pg8::Gemm g{Hb, (const bf16*)P_Win, M, NBF, D}; pg8::StaticOrder S; S.init(M, NBF, G, blk); pg8::EpiBf16P E{PROJ, DIN, BFMASK}; \
        pg8::gemm_phase<pg8::EpiBf16P, pg8::StaticOrder, true, true, 0>(lds, g, S, E); } while (0)
#define PH6() do { GEMM_IN_BF(); GEMM_IN_I8();     \
        { const int nsa_ = ((M / 256) * (2 * FF / 256)) % G, nsh_ = ((M / 256) * (NI8 / 256)) % G; if (nsh_) pool_fill(lds, wave, lane, blk, G, nsh_, nsa_ ? FILLA * (G - nsa_) : 0, FILLB, P0_ARGS); } } while (0)
#define PH7() p6_phase(lds, tid, blk, G, PROJ, kmean)
#define PH8() p7_phase(lds, blk, G, PROJ, Ob, kmean, sinks)
#define PH9() do { for (int row = blk * NWAVES + wave; row < M; row += G * NWAVES) row_groupnorm<WOQ ? 1 : 0>(Ob + (size_t)row * D, (unsigned char*)Hb + (size_t)row * D * (WOQ ? 1 : 2), rsh + row, lane); } while (0)
#define GEMM_WO_I8() do { pg8::Gemm g{Hb, (const bf16*)P_Wout, M, D, D / 2}; pg8::StaticOrder S; S.init(M, D, G, blk); pg8::EpiQ8Y E{Y8, D, YSC, rsh, P_cmaxo}; \
        pg8::gemm_phase<pg8::EpiQ8Y, pg8::StaticOrder, true, true, 1>(lds, g, S, E); } while (0)
#define PH10() do { if (WOQ) GEMM_WO_I8(); else GEMM_BF(Hb, P_Wout, D, D, Yb); } while (0)
#define PH11() RESID(true, (F2Q ? 1 : 0), 1, 1, XR, XR, 1, 1.0f, mx_post, f2_pre, -1, Hb)
#define PH12() do { if (F2Q) GEMM_GU_I8(P_Wgu2, P_cmax2, ctl + CW_ROWMAX2); else GEMM_GU(P_Wgu2); \
        { const int nsa_ = ((M / 256) * (2 * FF / 256)) % G, nsb_ = ((M / 256) * (NI8 / 256)) % G; const int sa_ = nsa_ ? G - nsa_ : 0, sb_ = nsb_ ? G - nsb_ : 0; \
          if (nsa_ && FILLA * sa_ + FILLB * sb_ <= POOL_C0 && FILLC * sa_ <= I_W) pool_fill(lds, wave, lane, blk, G, nsa_, POOL_C0, FILLC, P0_ARGS); } } while (0)
#define PH13() ACTQ(ctl + CW_ROWMAX2)
#define PH14() do { if (F2Q) GEMM_DN_I8(P_Wd2, P_cmax2); else GEMM_BF(ACT, P_Wd2, D, FF, Yb); } while (0)
#define PH15() RESID(false, 0, 1, 0, XR, out, 2, 0.5f, f2_post, f2_post, -1, Hb)
#define RUN(k, EN, PH) do { if (EN) { if (IN(k)) { PH(); } SEAM(k); } } while (0)
    RUN(0, true, PH0);
    RUN(1, true, PH1);
    RUN(2, true, PH2);
    RUN(3, F1Q, PH3);
    RUN(4, true, PH4);
    RUN(5, true, PH5);
    RUN(6, true, PH6);
    RUN(7, true, PH7);
    RUN(8, true, PH8);
    RUN(9, true, PH9);
    RUN(10, true, PH10);
    RUN(11, true, PH11);
    RUN(12, true, PH12);
    RUN(13, F2Q, PH13);
    RUN(14, true, PH14);
    if (IN(15)) { PH15(); }
#if PROBE_DUP
    if (IN(16)) { pg8::Gemm g{Hb, (const bf16*)P_Wgu2, M, 2 * FF, args.pk}; pg8::StaticOrder S; S.init(M, 2 * FF, G, blk); pg8::EpiSwiGLUI8 E{ACT, FF, rsh, P_cmax2, ctl + CW_ROWMAX2};
        pg8::gemm_phase<pg8::EpiSwiGLUI8, pg8::StaticOrder, true, true, 1>(lds, g, S, E); }
    if (IN(17)) { pg8::Gemm g{Hb, (const bf16*)P_Wgu2, M, 2 * FF, args.pk}; pg8::StaticOrder S; S.init(M, 2 * FF, G, blk); pg8::EpiNull E{(float*)ACT};
        pg8::gemm_phase<pg8::EpiNull, pg8::StaticOrder, true, true, 1>(lds, g, S, E); }
#ifndef PROBE_E
#define PROBE_E 0
#endif
    if (IN(18)) { typedef pg8::EpiSwiGLUI8T<(PROBE_E & 1) != 0, (PROBE_E & 2) != 0> EP; pg8::Gemm g{Hb, (const bf16*)P_Wgu2, M, 2 * FF, args.pk}; pg8::StaticOrder S; S.init(M, 2 * FF, G, blk); EP E{ACT, FF, rsh, P_cmax2, ctl + CW_ROWMAX2};
        pg8::gemm_phase<EP, pg8::StaticOrder, true, true, 1>(lds, g, S, E); }
    if (IN(19)) p7_phase<PROBE_E>(lds, blk, G, PROJ, Ob, kmean, sinks);
#endif
#undef IN
#undef SEAM
}

extern "C" void kernel_launch(void* const* d_in, const int* in_sizes, int n_in, void* d_out, int out_size, void* d_ws, size_t ws_size, hipStream_t stream) {
    static int grid = 0;
    if (grid == 0) {
        if (n_in != 21 || in_sizes[0] != M * D || out_size != M * D || ws_size < WS_END) { fprintf(stderr, "kernel_launch: unexpected shapes (n_in %d, in0 %d, out %d, ws %zu; need ws >= %zu); nothing launched\n", n_in, n_in > 0 ? in_sizes[0] : -1, out_size, ws_size, (size_t)WS_END); grid = -1; return; }
        int dev = 0, cus = 0, per_cu = 0;
        if (hipGetDevice(&dev) != hipSuccess || hipDeviceGetAttribute(&cus, hipDeviceAttributeMultiprocessorCount, dev) != hipSuccess) { fprintf(stderr, "kernel_launch: device query failed\n"); grid = -1; return; }
        if (hipFuncSetAttribute((const void*)mk_fwd, hipFuncAttributeMaxDynamicSharedMemorySize, LDS_BYTES) != hipSuccess) { fprintf(stderr, "kernel_launch: hipFuncSetAttribute failed\n"); grid = -1; return; }
        if (hipOccupancyMaxActiveBlocksPerMultiprocessor(&per_cu, (const void*)mk_fwd, NWAVES * 64, LDS_BYTES) != hipSuccess || per_cu < 1) { fprintf(stderr, "kernel_launch: occupancy query reports %d workgroups per CU\n", per_cu); }
        (void)hipGetLastError();
        grid = cus;
    }
    if (grid < 0) return;
    if (hipMemsetAsync((char*)d_ws + WS_CTL, 0, CTL_ZERO_BYTES, stream) != hipSuccess) { fprintf(stderr, "kernel_launch: hipMemsetAsync failed\n"); return; }
    Args a{};
    for (int i = 0; i < 21; ++i) a.in[i] = (const float*)d_in[i];
    a.out = (float*)d_out; a.ws = (unsigned char*)d_ws; a.pk = PROBE_PK; a.pad = 0;
    if (N_LAUNCHES == 1) { a.ph_lo = 0; a.ph_hi = N_PHASES; hipLaunchKernelGGL(mk_fwd, dim3(grid), dim3(NWAVES * 64), LDS_BYTES, stream, a); }
    else { for (int p = 0; p < N_PHASES + 4; ++p) { if ((p == 3 && !F1Q) || (p == 13 && !F2Q)) continue; a.ph_lo = p; a.ph_hi = p + 1; const int nrep = (p < N_PHASES ? 1 : 0) + (((PROBE_DUP) >> p) & 1);
            for (int r = 0; r < nrep; ++r) hipLaunchKernelGGL(mk_fwd, dim3(grid), dim3(NWAVES * 64), LDS_BYTES, stream, a); } }
    const hipError_t le = hipPeekAtLastError();
    if (le != hipSuccess) fprintf(stderr, "kernel_launch: launch failed: %s\n", hipGetErrorName(le));
}
```

```cpp
#include <hip/hip_runtime.h>
#include <cstdio>
#include <cstdint>
namespace pg8 {
#define PG8_LAS __attribute__((address_space(3)))
typedef unsigned short bf16_t;
typedef short bf16x8 __attribute__((ext_vector_type(8)));
typedef float f32x4 __attribute__((ext_vector_type(4)));
typedef unsigned u32x4 __attribute__((ext_vector_type(4)));
typedef int i32x4 __attribute__((ext_vector_type(4)));
constexpr int BM = 256, BK = 64, HALF = 128, HTB = HALF * BK * 2  , STAGE_BYTES = 8 * HTB, NXCD = 8, WGM = 8;

__host__ __device__ __forceinline__ int lds_byte(int r, int c) { const int st = (r >> 4) * 2 + (c >> 5), rr = r & 15, cc = c & 31, ob = rr * 64 + cc * 2; return st * 1024 + (ob ^ (((ob >> 9) & 1) << 5)); }
__host__ __device__ __forceinline__ void stage_rc(int b, int& R, int& C) { const int st = b / 1024, sb = b % 1024, swz = sb ^ (((sb >> 9) & 1) << 5); R = (st >> 1) * 16 + swz / 64; C = (st & 1) * 32 + (swz % 64) / 2; }
__host__ __device__ __forceinline__ int perm32(int rho) { const int n = rho >> 4, i = rho & 15; return 8 * (i >> 2) + 4 * n + (i & 3); }

struct Unit { int pm, pn; };
struct Gemm { const bf16_t* A; const bf16_t* Bt; int M, N, K; };

struct StaticOrder {
    int nM, nN, nwg, G, c;
    __host__ __device__ void init(int M, int N, int G_, int c_) { nM = M / BM; nN = N / BM; nwg = nM * nN; G = G_; c = c_; }
    __host__ __device__ bool next(int i, Unit& u) const {
        const long L = (long)i * G + c; if (L >= nwg) return false;
        int wgid = (int)L; { const int q = nwg / NXCD, r = nwg % NXCD, xcd = wgid % NXCD, off = wgid / NXCD; wgid = (xcd < r ? xcd * (q + 1) : r * (q + 1) + (xcd - r) * q) + off; }
        const int nig = WGM * nN, gid = wgid / nig, fm = gid * WGM, gsz = (nM - fm) < WGM ? (nM - fm) : WGM;
        u.pm = fm + ((wgid % nig) % gsz); u.pn = (wgid % nig) / gsz; return true;
    }
    __device__ __forceinline__ void a_ready(const Unit&) const {}
    __device__ __forceinline__ void done(const Unit&) const {}
};

__device__ __forceinline__ unsigned cvt_pk_bf16(float lo, float hi) { unsigned r; asm volatile("v_cvt_pk_bf16_f32 %0, %1, %2" : "=v"(r) : "v"(lo), "v"(hi)); return r; }
typedef float f32x2 __attribute__((ext_vector_type(2)));

__device__ __forceinline__ int nth_set(unsigned mask, int n) { for (int i = 0; i < n; ++i) mask &= mask - 1u; return __builtin_ctz(mask); }
struct EpiBf16P {
    static constexpr bool PERM = true, AFTER_DRAIN = false;
    bf16_t* O; int ldc; unsigned tmask;
    __device__ __forceinline__ void operator()(const f32x4 (&acc)[2][2][4][2], const Unit& u, int wr, int wc, int fr, int fq) const {
        const int row0 = u.pm * BM + wr * 64 + fr, col0 = (tmask ? nth_set(tmask, u.pn) : u.pn) * BM + wc * 32 + 8 * fq;
#pragma unroll
        for (int ai = 0; ai < 2; ++ai)
#pragma unroll
            for (int m = 0; m < 4; ++m) { bf16_t* rowp = O + (size_t)(row0 + ai * HALF + m * 16) * ldc + col0;
#pragma unroll
                for (int bj = 0; bj < 2; ++bj) { const f32x4 v0 = acc[ai][bj][m][0], v1 = acc[ai][bj][m][1];
                    u32x4 w; w.x = cvt_pk_bf16(v0[0], v0[1]); w.y = cvt_pk_bf16(v0[2], v0[3]); w.z = cvt_pk_bf16(v1[0], v1[1]); w.w = cvt_pk_bf16(v1[2], v1[3]);
                    *(u32x4*)(rowp + bj * HALF) = w; } }
    }
};
__device__ __forceinline__ float silu_mul(float g, float u) { const float e = __builtin_amdgcn_exp2f(g * -1.4426950408889634f); return g * __builtin_amdgcn_rcpf(1.0f + e) * u; }
struct EpiSwiGLU {
    static constexpr bool PERM = true, AFTER_DRAIN = false;
    bf16_t* O; int ldc;
    __device__ __forceinline__ void operator()(const f32x4 (&acc)[2][2][4][2], const Unit& u, int wr, int wc, int fr, int fq) const {
        const int row0 = u.pm * BM + wr * 64 + fr, col0 = u.pn * HALF + wc * 32 + 8 * fq;
#pragma unroll
        for (int ai = 0; ai < 2; ++ai)
#pragma unroll
            for (int m = 0; m < 4; ++m) { bf16_t* rowp = O + (size_t)(row0 + ai * HALF + m * 16) * ldc + col0;
                const f32x4 g0 = acc[ai][0][m][0], g1 = acc[ai][0][m][1], u0 = acc[ai][1][m][0], u1 = acc[ai][1][m][1];
                u32x4 w; w.x = cvt_pk_bf16(silu_mul(g0[0], u0[0]), silu_mul(g0[1], u0[1])); w.y = cvt_pk_bf16(silu_mul(g0[2], u0[2]), silu_mul(g0[3], u0[3]));
                w.z = cvt_pk_bf16(silu_mul(g1[0], u1[0]), silu_mul(g1[1], u1[1])); w.w = cvt_pk_bf16(silu_mul(g1[2], u1[2]), silu_mul(g1[3], u1[3]));
                *(u32x4*)rowp = w; }
    }
};

__device__ __forceinline__ f32x4 i2f4(const f32x4& a) { const i32x4 i = __builtin_bit_cast(i32x4, a); return (f32x4){(float)i[0], (float)i[1], (float)i[2], (float)i[3]}; }
struct EpiBf16I8 {
    static constexpr bool PERM = true, AFTER_DRAIN = false;
    bf16_t* O; int ldc; const float* sA; const unsigned* cmax; unsigned tmask;
    __device__ __forceinline__ void operator()(const f32x4 (&acc)[2][2][4][2], const Unit& u, int wr, int wc, int fr, int fq) const {
        const int row0 = u.pm * BM + wr * 64 + fr, col0 = u.pn * BM + wc * 32 + 8 * fq, ocol0 = col0 + (nth_set(tmask, u.pn) - u.pn) * BM;
        u32x4 craw[2][2]; float sav[2][4];
#pragma unroll
        for (int bj = 0; bj < 2; ++bj)
#pragma unroll
            for (int n = 0; n < 2; ++n) craw[bj][n] = *(const u32x4*)(cmax + col0 + bj * HALF + 4 * n);
#pragma unroll
        for (int ai = 0; ai < 2; ++ai)
#pragma unroll
            for (int m = 0; m < 4; ++m) sav[ai][m] = sA[row0 + ai * HALF + m * 16];
        asm volatile("" : "+v"(craw[0][0]), "+v"(craw[0][1]), "+v"(craw[1][0]), "+v"(craw[1][1]), "+v"(sav[0][0]), "+v"(sav[0][1]), "+v"(sav[0][2]), "+v"(sav[0][3]), "+v"(sav[1][0]), "+v"(sav[1][1]), "+v"(sav[1][2]), "+v"(sav[1][3]));
        f32x4 sb[2][2];
#pragma unroll
        for (int bj = 0; bj < 2; ++bj)
#pragma unroll
            for (int n = 0; n < 2; ++n) { const u32x4 c = craw[bj][n];
                sb[bj][n] = (f32x4){__uint_as_float(c[0]), __uint_as_float(c[1]), __uint_as_float(c[2]), __uint_as_float(c[3])} * (1.0f / 127.0f); }
#pragma unroll
        for (int ai = 0; ai < 2; ++ai)
#pragma unroll
            for (int m = 0; m < 4; ++m) { const int r = row0 + ai * HALF + m * 16; const float sa = sav[ai][m]; bf16_t* rowp = O + (size_t)r * ldc + ocol0;
#pragma unroll
                for (int bj = 0; bj < 2; ++bj) { const f32x4 v0 = i2f4(acc[ai][bj][m][0]) * (sb[bj][0] * sa), v1 = i2f4(acc[ai][bj][m][1]) * (sb[bj][1] * sa);
                    u32x4 w; w.x = cvt_pk_bf16(v0[0], v0[1]); w.y = cvt_pk_bf16(v0[2], v0[3]); w.z = cvt_pk_bf16(v1[0], v1[1]); w.w = cvt_pk_bf16(v1[2], v1[3]);
                    *(u32x4*)(rowp + bj * HALF) = w; } }
    }
};

struct EpiQ8Y {
    static constexpr bool PERM = true, AFTER_DRAIN = false;
    unsigned char* Q; int ldc; float* ysc; const float* sA; const unsigned* cmax;
    __device__ __forceinline__ void operator()(const f32x4 (&acc)[2][2][4][2], const Unit& u, int wr, int wc, int fr, int fq) const {
        const int row0 = u.pm * BM + wr * 64 + fr, col0 = u.pn * BM + wc * 32 + 8 * fq;
        u32x4 craw[2][2]; float sav[2][4];
#pragma unroll
        for (int bj = 0; bj < 2; ++bj)
#pragma unroll
            for (int n = 0; n < 2; ++n) craw[bj][n] = *(const u32x4*)(cmax + col0 + bj * HALF + 4 * n);
#pragma unroll
        for (int ai = 0; ai < 2; ++ai)
#pragma unroll
            for (int m = 0; m < 4; ++m) sav[ai][m] = sA[row0 + ai * HALF + m * 16];
        asm volatile("" : "+v"(craw[0][0]), "+v"(craw[0][1]), "+v"(craw[1][0]), "+v"(craw[1][1]), "+v"(sav[0][0]), "+v"(sav[0][1]), "+v"(sav[0][2]), "+v"(sav[0][3]), "+v"(sav[1][0]), "+v"(sav[1][1]), "+v"(sav[1][2]), "+v"(sav[1][3]));
        f32x4 sb[2][2];
#pragma unroll
        for (int bj = 0; bj < 2; ++bj)
#pragma unroll
            for (int n = 0; n < 2; ++n) { const u32x4 c = craw[bj][n];
                sb[bj][n] = (f32x4){__uint_as_float(c[0]), __uint_as_float(c[1]), __uint_as_float(c[2]), __uint_as_float(c[3])} * (1.0f / 127.0f); }
        const int ng = ldc >> 5;
#pragma unroll
        for (int ai = 0; ai < 2; ++ai)
#pragma unroll
            for (int m = 0; m < 4; ++m) { const int r = row0 + ai * HALF + m * 16; const float sa = sav[ai][m];
#pragma unroll
                for (int bj = 0; bj < 2; ++bj) { const f32x4 v0 = i2f4(acc[ai][bj][m][0]) * (sb[bj][0] * sa), v1 = i2f4(acc[ai][bj][m][1]) * (sb[bj][1] * sa);
                    float mx = fmaxf(fmaxf(fmaxf(fabsf(v0[0]), fabsf(v0[1])), fmaxf(fabsf(v0[2]), fabsf(v0[3]))), fmaxf(fmaxf(fabsf(v1[0]), fabsf(v1[1])), fmaxf(fabsf(v1[2]), fabsf(v1[3]))));
                    { auto r_ = __builtin_amdgcn_permlane16_swap(__float_as_uint(mx), __float_as_uint(mx), false, false); mx = fmaxf(__uint_as_float(r_[0]), __uint_as_float(r_[1])); }
                    { auto r_ = __builtin_amdgcn_permlane32_swap(__float_as_uint(mx), __float_as_uint(mx), false, false); mx = fmaxf(__uint_as_float(r_[0]), __uint_as_float(r_[1])); }
                    const float inv = mx > 0.f ? 127.0f * __builtin_amdgcn_rcpf(mx) : 0.f;
                    const f32x4 y0 = v0 * inv + (12582912.0f + 128.0f), y1 = v1 * inv + (12582912.0f + 128.0f);
                    typedef unsigned u32x2 __attribute__((ext_vector_type(2)));
                    u32x2 w; w.x = __builtin_amdgcn_perm(__builtin_amdgcn_perm(__float_as_uint(y0[3]), __float_as_uint(y0[2]), 0x0c0c0400u), __builtin_amdgcn_perm(__float_as_uint(y0[1]), __float_as_uint(y0[0]), 0x0c0c0400u), 0x05040100u);
                    w.y = __builtin_amdgcn_perm(__builtin_amdgcn_perm(__float_as_uint(y1[3]), __float_as_uint(y1[2]), 0x0c0c0400u), __builtin_amdgcn_perm(__float_as_uint(y1[1]), __float_as_uint(y1[0]), 0x0c0c0400u), 0x05040100u);
                    const int c = col0 + bj * HALF;
                    *(u32x2*)(Q + (size_t)r * ldc + c) = w;
                    if (fq == 0) ysc[(size_t)r * ng + (c >> 5)] = mx * (1.0f / 127.0f); } }
    }
};
template <bool NOLD = false, bool NORM = false> struct EpiSwiGLUI8T {
    static constexpr bool PERM = true, AFTER_DRAIN = false;
    bf16_t* O; int ldc; const float* sA; const unsigned* cmax; unsigned* rowmax;
    __device__ __forceinline__ void operator()(const f32x4 (&acc)[2][2][4][2], const Unit& u, int wr, int wc, int fr, int fq) const {
        const int row0 = u.pm * BM + wr * 64 + fr, col0 = u.pn * HALF + wc * 32 + 8 * fq, bcol0 = u.pn * BM + wc * 32 + 8 * fq;
        f32x4 sb[2][2];
#pragma unroll
        for (int bj = 0; bj < 2; ++bj)
#pragma unroll
            for (int n = 0; n < 2; ++n) { u32x4 c = (u32x4){0x3f800000u, 0x3f900000u, 0x3fa00000u, 0x3fb00000u}; if (!NOLD) c = *(const u32x4*)(cmax + bcol0 + bj * HALF + 4 * n);
                sb[bj][n] = (f32x4){__uint_as_float(c[0]), __uint_as_float(c[1]), __uint_as_float(c[2]), __uint_as_float(c[3])} * (1.0f / 127.0f); }
#pragma unroll
        for (int ai = 0; ai < 2; ++ai)
#pragma unroll
            for (int m = 0; m < 4; ++m) { const int r = row0 + ai * HALF + m * 16; const float sa = NOLD ? 0.01f : sA[r]; bf16_t* rowp = O + (size_t)r * ldc + col0;
                const f32x4 g0 = i2f4(acc[ai][0][m][0]) * (sb[0][0] * sa), g1 = i2f4(acc[ai][0][m][1]) * (sb[0][1] * sa);
                const f32x4 u0 = i2f4(acc[ai][1][m][0]) * (sb[1][0] * sa), u1 = i2f4(acc[ai][1][m][1]) * (sb[1][1] * sa);
                float v[8];
#pragma unroll
                for (int e = 0; e < 4; ++e) { v[e] = silu_mul(g0[e], u0[e]); v[4 + e] = silu_mul(g1[e], u1[e]); }
                u32x4 w; w.x = cvt_pk_bf16(v[0], v[1]); w.y = cvt_pk_bf16(v[2], v[3]); w.z = cvt_pk_bf16(v[4], v[5]); w.w = cvt_pk_bf16(v[6], v[7]);
                *(u32x4*)rowp = w;
                if (!NORM) { float mx = 0.f;
#pragma unroll
                for (int e = 0; e < 8; ++e) mx = fmaxf(mx, fabsf(v[e]));
                mx = fmaxf(mx, __shfl_xor(mx, 16)); mx = fmaxf(mx, __shfl_xor(mx, 32));
                if (fq == 0) atomicMax(rowmax + r, __float_as_uint(mx)); } }
    }
};

typedef EpiSwiGLUI8T<false, false> EpiSwiGLUI8;

__device__ __forceinline__ f32x2 silu_mul_pk(f32x2 g, f32x2 u) {
    const f32x2 t = g * -1.4426950408889634f;
    f32x2 e; e.x = __builtin_amdgcn_exp2f(t.x); e.y = __builtin_amdgcn_exp2f(t.y);
    const f32x2 d = e + 1.0f;
    f32x2 r; r.x = __builtin_amdgcn_rcpf(d.x); r.y = __builtin_amdgcn_rcpf(d.y);
    return (g * u) * r;
}
struct EpiSwiGLUQ {
    static constexpr bool PERM = true, AFTER_DRAIN = false;
    signed char* Q; int ldc; float* lsc; int nls; const float* sA; const unsigned* cmax; unsigned* rowmax;
    __device__ __forceinline__ void operator()(const f32x4 (&acc)[2][2][4][2], const Unit& u, int wr, int wc, int fr, int fq) const {
        const int row0 = u.pm * BM + wr * 64 + fr, col0 = u.pn * HALF + wc * 32 + 8 * fq, bcol0 = u.pn * BM + wc * 32 + 8 * fq;
        u32x4 craw[2][2]; float sav[2][4];
#pragma unroll
        for (int bj = 0; bj < 2; ++bj)
#pragma unroll
            for (int n = 0; n < 2; ++n) craw[bj][n] = *(const u32x4*)(cmax + bcol0 + bj * HALF + 4 * n);
#pragma unroll
        for (int ai = 0; ai < 2; ++ai)
#pragma unroll
            for (int m = 0; m < 4; ++m) sav[ai][m] = sA[row0 + ai * HALF + m * 16];
        asm volatile("" : "+v"(craw[0][0]), "+v"(craw[0][1]), "+v"(craw[1][0]), "+v"(craw[1][1]), "+v"(sav[0][0]), "+v"(sav[0][1]), "+v"(sav[0][2]), "+v"(sav[0][3]), "+v"(sav[1][0]), "+v"(sav[1][1]), "+v"(sav[1][2]), "+v"(sav[1][3]));
        f32x4 sb[2][2];
#pragma unroll
        for (int bj = 0; bj < 2; ++bj)
#pragma unroll
            for (int n = 0; n < 2; ++n) { const u32x4 c = craw[bj][n];
                sb[bj][n] = (f32x4){__uint_as_float(c[0]), __uint_as_float(c[1]), __uint_as_float(c[2]), __uint_as_float(c[3])} * (1.0f / 127.0f); }
#pragma unroll
        for (int ai = 0; ai < 2; ++ai)
#pragma unroll
            for (int m = 0; m < 4; ++m) { const int r = row0 + ai * HALF + m * 16; const float sa = sav[ai][m];
                const f32x4 g0 = i2f4(acc[ai][0][m][0]) * (sb[0][0] * sa), g1 = i2f4(acc[ai][0][m][1]) * (sb[0][1] * sa);
                const f32x4 u0 = i2f4(acc[ai][1][m][0]) * (sb[1][0] * sa), u1 = i2f4(acc[ai][1][m][1]) * (sb[1][1] * sa);
                f32x2 v[4];
                v[0] = silu_mul_pk((f32x2){g0[0], g0[1]}, (f32x2){u0[0], u0[1]}); v[1] = silu_mul_pk((f32x2){g0[2], g0[3]}, (f32x2){u0[2], u0[3]});
                v[2] = silu_mul_pk((f32x2){g1[0], g1[1]}, (f32x2){u1[0], u1[1]}); v[3] = silu_mul_pk((f32x2){g1[2], g1[3]}, (f32x2){u1[2], u1[3]});
                float mx = 0.f;
#pragma unroll
                for (int e = 0; e < 4; ++e) mx = fmaxf(mx, fmaxf(fabsf(v[e].x), fabsf(v[e].y)));
                { auto r_ = __builtin_amdgcn_permlane16_swap(__float_as_uint(mx), __float_as_uint(mx), false, false); mx = fmaxf(__uint_as_float(r_[0]), __uint_as_float(r_[1])); }
                { auto r_ = __builtin_amdgcn_permlane32_swap(__float_as_uint(mx), __float_as_uint(mx), false, false); mx = fmaxf(__uint_as_float(r_[0]), __uint_as_float(r_[1])); }
                const float inv = mx > 0.f ? 127.0f * __builtin_amdgcn_rcpf(mx) : 0.f;
                unsigned q[8];
#pragma unroll
                for (int e = 0; e < 4; ++e) { const f32x2 y = v[e] * inv + (12582912.0f + 128.0f); q[2 * e] = __float_as_uint(y.x); q[2 * e + 1] = __float_as_uint(y.y); }
                typedef unsigned u32x2 __attribute__((ext_vector_type(2)));
                u32x2 w; w.x = __builtin_amdgcn_perm(__builtin_amdgcn_perm(q[3], q[2], 0x0c0c0400u), __builtin_amdgcn_perm(q[1], q[0], 0x0c0c0400u), 0x05040100u);
                w.y = __builtin_amdgcn_perm(__builtin_amdgcn_perm(q[7], q[6], 0x0c0c0400u), __builtin_amdgcn_perm(q[5], q[4], 0x0c0c0400u), 0x05040100u);
                *(u32x2*)(Q + (size_t)r * ldc + col0) = w;
                if (fq == 0) { lsc[(size_t)r * nls + u.pn * 4 + wc] = mx * (1.0f / 127.0f); atomicMax(rowmax + r, __float_as_uint(mx)); } }
    }
};
struct EpiNull {
    static constexpr bool PERM = true, AFTER_DRAIN = false;
    float* O;
    __device__ __forceinline__ void operator()(const f32x4 (&acc)[2][2][4][2], const Unit& u, int wr, int wc, int fr, int fq) const {
        f32x4 s = (f32x4){0.f, 0.f, 0.f, 0.f};
#pragma unroll
        for (int ai = 0; ai < 2; ++ai)
#pragma unroll
            for (int bj = 0; bj < 2; ++bj)
#pragma unroll
                for (int m = 0; m < 4; ++m)
#pragma unroll
                    for (int n = 0; n < 2; ++n) s += acc[ai][bj][m][n];
        if (s[0] + s[1] + s[2] + s[3] == 1.2345e-33f) O[u.pm * 7 + u.pn + fr] = s[0];
    }
};
template <class Epi, class Sched, bool ALIGN_EPI = false, bool SP2 = false, int MK = 0>
__device__ __forceinline__ void gemm_phase(PG8_LAS unsigned char* lds, const Gemm g, const Sched& S, const Epi& E) {
    const int tid = threadIdx.x, wid = __builtin_amdgcn_readfirstlane(tid >> 6), lane = tid & 63, wr = wid >> 2, wc = wid & 3, fr = lane & 15, fq = lane >> 4;
    const int K = g.K, nt = K / BK;
    unsigned voffA[2], voffB[2];
#pragma unroll
    for (int i = 0; i < 2; ++i) { int R, C; stage_rc(tid * 16 + i * 8192, R, C); const int Rb = Epi::PERM ? ((R & ~31) + perm32(R & 31)) : R;
        voffA[i] = (unsigned)(R * K + C) * 2u; voffB[i] = (unsigned)(Rb * K + C) * 2u; }
    const size_t kstep = (size_t)(BK * 2);
    const size_t hstep = (size_t)HALF * K * 2;
    const size_t tstep = 2 * hstep;
    const unsigned ldsw = (unsigned)wid * 1024u;
    const int aoff = lds_byte(wr * 64 + fr, fq * 8), boff = lds_byte(wc * 32 + fr, fq * 8);
#define PG8_SA(b, h) (((b) * 2 + (h)) * HTB)
#define PG8_SB(b, h) ((4 + (b) * 2 + (h)) * HTB)
#define PG8_STAGE(bufoff, gbase, voff) do { _Pragma("unroll") for (int _i = 0; _i < 2; ++_i) \
        __builtin_amdgcn_global_load_lds((const unsigned*)((const char*)(gbase) + (voff)[_i]), (PG8_LAS unsigned*)(lds + (bufoff) + ldsw + _i * 8192), 16, 0, 0); } while (0)
#define PG8_LDA(dst, b, h) do { _Pragma("unroll") for (int m = 0; m < 4; ++m) _Pragma("unroll") for (int k = 0; k < 2; ++k) dst[m][k] = *(const PG8_LAS bf16x8*)(lds + PG8_SA(b, h) + aoff + m * 2048 + k * 1024); } while (0)
#define PG8_LDB(dst, b, h) do { _Pragma("unroll") for (int n = 0; n < 2; ++n) _Pragma("unroll") for (int k = 0; k < 2; ++k) dst[n][k] = *(const PG8_LAS bf16x8*)(lds + PG8_SB(b, h) + boff + n * 2048 + k * 1024); } while (0)
#define PG8_MMA(ai, bj, At, Bt) do { __builtin_amdgcn_s_setprio(1); _Pragma("unroll") for (int m = 0; m < 4; ++m) _Pragma("unroll") for (int n = 0; n < 2; ++n) _Pragma("unroll") for (int k = 0; k < 2; ++k) \
        { if constexpr (MK == 0) acc[ai][bj][m][n] = __builtin_amdgcn_mfma_f32_16x16x32_bf16(Bt[n][k], At[m][k], acc[ai][bj][m][n], 0, 0, 0); \
          else acc[ai][bj][m][n] = __builtin_bit_cast(f32x4, __builtin_amdgcn_mfma_i32_16x16x64_i8(__builtin_bit_cast(i32x4, Bt[n][k]), __builtin_bit_cast(i32x4, At[m][k]), __builtin_bit_cast(i32x4, acc[ai][bj][m][n]), 0, 0, 0)); } \
        __builtin_amdgcn_s_setprio(0); } while (0)
#define PG8_WAIT_V(n) asm volatile("s_waitcnt vmcnt(" #n ")" ::: "memory")
#define PG8_WAIT_L(n) asm volatile("s_waitcnt lgkmcnt(" #n ")" ::: "memory")
#define PG8_BAR __builtin_amdgcn_s_barrier()
#define PG8_SCHED __builtin_amdgcn_sched_barrier(0)
    Unit cur, nxt; int ui = 0;
    if (!S.next(0, cur)) return;
    f32x4 acc[2][2][4][2];
#pragma unroll
    for (int a = 0; a < 2; ++a)
#pragma unroll
        for (int b = 0; b < 2; ++b)
#pragma unroll
            for (int m = 0; m < 4; ++m)
#pragma unroll
                for (int n = 0; n < 2; ++n) acc[a][b][m][n] = (f32x4){0.f, 0.f, 0.f, 0.f};
    bf16x8 At[4][2], B0[2][2], B1[2][2];
    const char* cA = (const char*)g.A + (size_t)cur.pm * tstep; const char* cB = (const char*)g.Bt + (size_t)cur.pn * tstep;
    S.a_ready(cur);
    if constexpr (SP2) {
        PG8_STAGE(PG8_SB(0, 0), cB, voffB); PG8_STAGE(PG8_SB(0, 1), cB + hstep, voffB); PG8_STAGE(PG8_SA(0, 0), cA, voffA); PG8_STAGE(PG8_SA(0, 1), cA + hstep, voffA);
        if (wr == 1) PG8_BAR;
        PG8_WAIT_V(2); PG8_BAR;
        PG8_STAGE(PG8_SB(1, 0), cB + kstep, voffB); PG8_STAGE(PG8_SA(1, 0), cA + kstep, voffA); PG8_STAGE(PG8_SB(1, 1), cB + hstep + kstep, voffB);
        PG8_WAIT_V(6); PG8_BAR;
    } else {
        PG8_STAGE(PG8_SB(0, 0), cB, voffB); PG8_STAGE(PG8_SA(0, 0), cA, voffA); PG8_STAGE(PG8_SB(0, 1), cB + hstep, voffB); PG8_STAGE(PG8_SA(0, 1), cA + hstep, voffA);
        if (wr == 1) PG8_BAR;
        PG8_WAIT_V(4); PG8_BAR;
        PG8_STAGE(PG8_SB(1, 0), cB + kstep, voffB); PG8_STAGE(PG8_SA(1, 0), cA + kstep, voffA); PG8_STAGE(PG8_SB(1, 1), cB + hstep + kstep, voffB);
        PG8_WAIT_V(6); PG8_BAR;
    }
    for (;;) {
        const bool has_next = S.next(ui + 1, nxt);
        const char* nA = has_next ? (const char*)g.A + (size_t)nxt.pm * tstep : cA; const char* nB = has_next ? (const char*)g.Bt + (size_t)nxt.pn * tstep : cB;
        for (int t = 0; t < nt; t += 2) {
            const bool last = (t == nt - 2);
            const char* a1 = cA + (size_t)(t + 1) * kstep;
            const char* a2 = last ? nA : cA + (size_t)(t + 2) * kstep; const char* b2 = last ? nB : cB + (size_t)(t + 2) * kstep;
            const char* a3 = a2 + kstep; const char* b3 = b2 + kstep;
            if (last && has_next) S.a_ready(nxt);
            if constexpr (SP2) {
            PG8_LDB(B0, 0, 0); PG8_LDB(B1, 0, 1); PG8_SCHED; PG8_LDA(At, 0, 0); PG8_STAGE(PG8_SA(1, 1), a1 + hstep, voffA);
            PG8_WAIT_V(8); PG8_WAIT_L(0); PG8_BAR; PG8_MMA(0, 0, At, B0); PG8_MMA(0, 1, At, B1); PG8_BAR; PG8_SCHED;
            PG8_LDA(At, 0, 1); PG8_STAGE(PG8_SB(0, 0), b2, voffB); PG8_STAGE(PG8_SB(0, 1), b2 + hstep, voffB); PG8_STAGE(PG8_SA(0, 0), a2, voffA);
            PG8_WAIT_V(8); PG8_WAIT_L(0); PG8_BAR; PG8_MMA(1, 0, At, B0); PG8_MMA(1, 1, At, B1); PG8_BAR; PG8_SCHED;
            PG8_LDB(B0, 1, 0); PG8_LDB(B1, 1, 1); PG8_SCHED; PG8_LDA(At, 1, 0); PG8_STAGE(PG8_SA(0, 1), a2 + hstep, voffA);
            PG8_WAIT_V(8); PG8_WAIT_L(0); PG8_BAR; PG8_MMA(0, 0, At, B0); PG8_MMA(0, 1, At, B1); PG8_BAR; PG8_SCHED;
            PG8_LDA(At, 1, 1); PG8_STAGE(PG8_SB(1, 0), b3, voffB); PG8_STAGE(PG8_SB(1, 1), b3 + hstep, voffB); PG8_STAGE(PG8_SA(1, 0), a3, voffA);
            PG8_WAIT_V(8); PG8_WAIT_L(0); PG8_BAR; PG8_MMA(1, 0, At, B0); PG8_MMA(1, 1, At, B1); PG8_BAR; PG8_SCHED;
            } else {
            PG8_LDB(B0, 0, 0); PG8_SCHED; PG8_LDA(At, 0, 0); PG8_STAGE(PG8_SA(1, 1), a1 + hstep, voffA);
            PG8_WAIT_L(8); PG8_BAR; PG8_WAIT_L(0); PG8_MMA(0, 0, At, B0); PG8_BAR; PG8_SCHED;
            PG8_LDB(B1, 0, 1); PG8_STAGE(PG8_SB(0, 0), b2, voffB);
            PG8_BAR; PG8_WAIT_L(0); PG8_MMA(0, 1, At, B1); PG8_BAR;
            PG8_LDA(At, 0, 1); PG8_STAGE(PG8_SA(0, 0), a2, voffA);
            PG8_BAR; PG8_WAIT_L(0); PG8_MMA(1, 0, At, B0); PG8_BAR; PG8_SCHED;
            PG8_STAGE(PG8_SB(0, 1), b2 + hstep, voffB);
            PG8_WAIT_V(6); PG8_BAR; PG8_MMA(1, 1, At, B1); PG8_BAR;
            PG8_LDB(B0, 1, 0); PG8_SCHED; PG8_LDA(At, 1, 0); PG8_STAGE(PG8_SA(0, 1), a2 + hstep, voffA);
            PG8_WAIT_L(8); PG8_BAR; PG8_WAIT_L(0); PG8_MMA(0, 0, At, B0); PG8_BAR; PG8_SCHED;
            PG8_LDB(B1, 1, 1); PG8_STAGE(PG8_SB(1, 0), b3, voffB);
            PG8_BAR; PG8_WAIT_L(0); PG8_MMA(0, 1, At, B1); PG8_BAR;
            PG8_LDA(At, 1, 1); PG8_STAGE(PG8_SA(1, 0), a3, voffA);
            PG8_BAR; PG8_WAIT_L(0); PG8_MMA(1, 0, At, B0); PG8_BAR; PG8_SCHED;
            PG8_STAGE(PG8_SB(1, 1), b3 + hstep, voffB);
            PG8_WAIT_V(6); PG8_BAR; PG8_MMA(1, 1, At, B1); PG8_BAR;
            }
        }
        if constexpr (ALIGN_EPI) { if (wr == 0) PG8_BAR; }
        if constexpr (!Epi::AFTER_DRAIN) { E(acc, cur, wr, wc, fr, fq); S.done(cur); }
        if (!has_next) break;
#pragma unroll
        for (int a = 0; a < 2; ++a)
#pragma unroll
            for (int b = 0; b < 2; ++b)
#pragma unroll
                for (int m = 0; m < 4; ++m)
#pragma unroll
                    for (int n = 0; n < 2; ++n) acc[a][b][m][n] = (f32x4){0.f, 0.f, 0.f, 0.f};
        cur = nxt; cA = nA; cB = nB; ++ui;
        if constexpr (ALIGN_EPI) { if (wr == 1) PG8_BAR; }
    }
    PG8_WAIT_V(0);
    if constexpr (!ALIGN_EPI) { if (wr == 0) PG8_BAR; }
    PG8_BAR;
    if constexpr (Epi::AFTER_DRAIN) { E.fused(acc, cur, wr, wc, fr, fq, lds, wid, lane); S.done(cur); }
#undef PG8_SA
#undef PG8_SB
#undef PG8_STAGE
#undef PG8_LDA
#undef PG8_LDB
#undef PG8_MMA
#undef PG8_WAIT_V
#undef PG8_WAIT_L
#undef PG8_BAR
#undef PG8_SCHED
}
}

namespace att {
#define ATT_LAS __attribute__((address_space(3)))
typedef unsigned short bf16;
typedef short bf16x8 __attribute__((ext_vector_type(8)));
typedef short s16x4 __attribute__((ext_vector_type(4)));
typedef float f32x16 __attribute__((ext_vector_type(16)));
typedef float f32x4 __attribute__((ext_vector_type(4)));
typedef unsigned u32x4 __attribute__((ext_vector_type(4)));
typedef unsigned u32x2 __attribute__((ext_vector_type(2)));
constexpr int SHM_T = 16384;
constexpr int OFF_V = 0, OFF_K = 2 * SHM_T, OFF_KM = 4 * SHM_T, OFF_WS = OFF_KM + 8192, ATT_LDS = OFF_WS + 8 * 64 * 4;
constexpr int PS = 5632;
constexpr int OPITCH = 4096;
constexpr float LOG2E = 1.4426950408889634f;
constexpr float C2 = 0.08838834764831845f * 1.4426950408889634f;
constexpr float THR = 8.f;
#define ATT_KSWZ(row, colB) ((row) * 256 + ((colB) ^ (((row) & 7) << 4)))
__device__ __forceinline__ int v_st(int k, int c) { const int kk = (k & ~0xC) | ((k & 4) << 1) | ((k & 8) >> 1); return ((kk >> 3) * 4 + (c >> 5)) * 512 + ((kk & 7) * 32 + (c & 31)) * 2; }
__device__ __forceinline__ int v_rd_base(int lane) { return ((lane & 3) << 3) | (((lane >> 2) & 3) << 6) | (((lane >> 4) & 1) << 5) | (((lane >> 5) & 1) << 8); }
constexpr int v_rd_off(int d0, int ks, int half) { return d0 * 512 + ks * 4096 + half * 2048; }
__device__ __forceinline__ int crow(int r, int hi) { return (r & 3) + 8 * (r >> 2) + 4 * hi; }
__device__ __forceinline__ unsigned cvtpk(float lo, float hi) { unsigned r; asm volatile("v_cvt_pk_bf16_f32 %0, %1, %2" : "=v"(r) : "v"(lo), "v"(hi)); return r; }

__device__ __forceinline__ void pv_tile(f32x16* o, unsigned vb, bf16x8 pa0, bf16x8 pa1, bf16x8 pa2, bf16x8 pa3) {
#define ATT_TRRD(dst, off) asm volatile("ds_read_b64_tr_b16 %0, %1 offset:%2" : "=&v"(dst) : "v"(vb), "i"(off) : "memory")
#define ATT_TR8(L, ks) do { ATT_TRRD(L[0], v_rd_off(0, ks, 0)); ATT_TRRD(L[1], v_rd_off(0, ks, 1)); ATT_TRRD(L[2], v_rd_off(1, ks, 0)); ATT_TRRD(L[3], v_rd_off(1, ks, 1)); \
        ATT_TRRD(L[4], v_rd_off(2, ks, 0)); ATT_TRRD(L[5], v_rd_off(2, ks, 1)); ATT_TRRD(L[6], v_rd_off(3, ks, 0)); ATT_TRRD(L[7], v_rd_off(3, ks, 1)); } while (0)
#define ATT_WAITV(n, L) asm volatile("s_waitcnt lgkmcnt(" #n ")" : "+v"(L[0]), "+v"(L[1]), "+v"(L[2]), "+v"(L[3]), "+v"(L[4]), "+v"(L[5]), "+v"(L[6]), "+v"(L[7]) :: "memory")
#define ATT_PV4(L, pa) do { _Pragma("unroll") for (int d0 = 0; d0 < 4; ++d0) \
        o[d0] = __builtin_amdgcn_mfma_f32_32x32x16_bf16(pa, (bf16x8){L[2 * d0][0], L[2 * d0][1], L[2 * d0][2], L[2 * d0][3], L[2 * d0 + 1][0], L[2 * d0 + 1][1], L[2 * d0 + 1][2], L[2 * d0 + 1][3]}, o[d0], 0, 0, 0); } while (0)
    s16x4 A[8], B[8];
    ATT_TR8(A, 0); ATT_TR8(B, 1); ATT_WAITV(8, A); ATT_PV4(A, pa0);
    ATT_TR8(A, 2); ATT_WAITV(8, B); ATT_PV4(B, pa1);
    ATT_TR8(B, 3); ATT_WAITV(8, A); ATT_PV4(A, pa2);
    ATT_WAITV(0, B); ATT_PV4(B, pa3);
#undef ATT_PV4
#undef ATT_WAITV
#undef ATT_TR8
#undef ATT_TRRD
}

template <int MODE, int VAR = 0>
__device__ __forceinline__ void attn_unit(ATT_LAS unsigned char* lds, const bf16* proj, bf16* O, const float* kmean, const float* sinks, int b, int kvh, int t0) {
    int tid_ = threadIdx.x; asm volatile("" : "+v"(tid_));
    const int tid = tid_, wid = __builtin_amdgcn_readfirstlane(tid >> 6), lane = tid & 63, r32 = lane & 31, hi = lane >> 5;
    int head, tw0, qcol, kcol, vcol, ocol;
    if (MODE == 0) { head = kvh * 8 + wid; tw0 = t0; qcol = head * 128; kcol = 2048 + kvh * 128; vcol = 2304 + kvh * 128; ocol = head * 128; }
    else { head = kvh * 4 + (wid >> 1); tw0 = t0 + 32 * (wid & 1); qcol = 2560 + head * 128; kcol = 4608 + kvh * 128; vcol = 5120 + kvh * 128; ocol = 2048 + head * 128; }
    const int tq = tw0 + r32;
    const float slope2 = exp2f(-0.5f * (float)(head + 1)) * LOG2E;
    const size_t rowbase = (size_t)b * 4096;
    bf16x8 qr[8];
    { const bf16* qp = proj + (rowbase + tq) * PS + qcol + hi * 8;
#pragma unroll
      for (int d0 = 0; d0 < 8; ++d0) qr[d0] = *(const bf16x8*)(qp + d0 * 16); }
    ATT_LAS float* wsf = (ATT_LAS float*)(lds + OFF_WS) + wid * 64; ATT_LAS float* li_l = wsf; ATT_LAS float* al_l = wsf + 32;
    const float NEG = -__builtin_inff();
    unsigned selmask = 0u; const int own_blk = t0 >> 8;
    int j_lo, j_hi;
    if (MODE == 0) { j_lo = (t0 - 127) > 0 ? ((t0 - 127) >> 6) : 0; j_hi = ((t0 + 31) >> 6) + 1; }
    else { j_lo = 0; j_hi = (t0 >> 6) + 1; }
    const int NT = j_hi - j_lo;
    unsigned kgo[2], vgo[2];
#pragma unroll
    for (int i = 0; i < 2; ++i) { const int L = (i * 8 + wid) * 1024 + lane * 16;
        { const int row = L >> 8, colB = (L & 255) ^ ((row & 7) << 4); kgo[i] = (unsigned)(row * PS * 2 + colB); }
        { const int sub = L >> 9, e = (L & 511) >> 1, kk = ((sub >> 2) << 3) | (e >> 5), c = ((sub & 3) << 5) | (e & 31), k = (kk & ~0xC) | ((kk & 4) << 1) | ((kk & 8) >> 1); vgo[i] = (unsigned)(k * PS * 2 + c * 2); } }
    const unsigned char* kgb = (const unsigned char*)(proj + rowbase * PS + kcol) + (size_t)j_lo * 64 * PS * 2;
    const unsigned char* vgb = (const unsigned char*)(proj + rowbase * PS + vcol) + (size_t)j_lo * 64 * PS * 2;
#define ATT_DMA_K(t, bf) do { if (VAR & 8) break; const unsigned char* g_ = kgb + (size_t)(t) * (64 * PS * 2); _Pragma("unroll") for (int i = 0; i < 2; ++i) \
        __builtin_amdgcn_global_load_lds((const unsigned*)(g_ + kgo[i]), (ATT_LAS unsigned*)(lds + OFF_K + (bf) + (i * 8 + wid) * 1024), 16, 0, 0); } while (0)
#define ATT_DMA_V(t, bf) do { if (VAR & 8) break; const unsigned char* g_ = vgb + (size_t)(t) * (64 * PS * 2); _Pragma("unroll") for (int i = 0; i < 2; ++i) \
        __builtin_amdgcn_global_load_lds((const unsigned*)(g_ + vgo[i]), (ATT_LAS unsigned*)(lds + OFF_V + (bf) + (i * 8 + wid) * 1024), 16, 0, 0); } while (0)
    f32x4 kmv = {};
    if (MODE == 1) kmv = *(const f32x4*)(kmean + ((size_t)(b * 4 + kvh) * 16 + (tid >> 5)) * 128 + (tid & 31) * 4);
    ATT_DMA_K(0, 0); ATT_DMA_V(0, 0);
    if (NT > 1) ATT_DMA_K(1, SHM_T);
    if (MODE == 1) {
        {
            const int n = tid >> 5, c4 = (tid & 31) * 4;
            const f32x4 v = kmv;
            const unsigned h01 = cvtpk(v[0], v[1]), h23 = cvtpk(v[2], v[3]);
            const float r0 = v[0] - __uint_as_float(h01 << 16), r1 = v[1] - __uint_as_float(h01 & 0xffff0000u), r2 = v[2] - __uint_as_float(h23 << 16), r3 = v[3] - __uint_as_float(h23 & 0xffff0000u);
            const unsigned l01 = cvtpk(r0, r1), l23 = cvtpk(r2, r3);
            const int off = n * 256 + ((c4 * 2) ^ ((n & 7) << 4));
            *(ATT_LAS u32x2*)(lds + OFF_KM + off) = (u32x2){h01, h23};
            *(ATT_LAS u32x2*)(lds + OFF_KM + off + 16 * 256) = (u32x2){l01, l23};
        }
        asm volatile("s_waitcnt lgkmcnt(0)" ::: "memory"); __builtin_amdgcn_s_barrier(); asm volatile("" ::: "memory");
        f32x16 gp = {};
#pragma unroll
        for (int d0 = 0; d0 < 8; ++d0) { const bf16x8 kf = *(const ATT_LAS bf16x8*)(lds + OFF_KM + ATT_KSWZ(r32, d0 * 32 + hi * 16));
            gp = __builtin_amdgcn_mfma_f32_32x32x16_bf16(kf, qr[d0], gp, 0, 0, 0); }
        float own[8], par[8], gn[16];
#pragma unroll
        for (int i = 0; i < 8; ++i) own[i] = gp[i] + gp[i + 8];
#pragma unroll
        for (int i = 0; i < 8; ++i) { auto rr = __builtin_amdgcn_permlane32_swap(__float_as_uint(own[i]), __float_as_uint(own[i]), false, false); par[i] = __uint_as_float(hi ? rr[0] : rr[1]); }
#pragma unroll
        for (int i = 0; i < 8; ++i) { const int nlo = (i & 3) + 8 * (i >> 2); gn[nlo] = hi ? par[i] : own[i]; gn[nlo + 4] = hi ? own[i] : par[i]; }
#pragma unroll
        for (int n = 0; n < 16; ++n) gn[n] = (n < own_blk) ? gn[n] : NEG;
#pragma unroll
        for (int k = 0; k < 3; ++k) { float best = NEG; int bi = -1;
#pragma unroll
            for (int n = 0; n < 16; ++n) { const bool gt = gn[n] > best; best = gt ? gn[n] : best; bi = gt ? n : bi; }
            if (bi >= 0) selmask |= 1u << bi;
#pragma unroll
            for (int n = 0; n < 16; ++n) gn[n] = (n == bi) ? NEG : gn[n]; }
    }
#pragma unroll
    for (int d0 = 0; d0 < 8; ++d0) { u32x4 w = __builtin_bit_cast(u32x4, qr[d0]);
#pragma unroll
        for (int e = 0; e < 4; ++e) w[e] = cvtpk(__uint_as_float(w[e] << 16) * C2, __uint_as_float(w[e] & 0xffff0000u) * C2);
        qr[d0] = __builtin_bit_cast(bf16x8, w); }
    float m_reg, l_reg;
    if (MODE == 0) { m_reg = sinks[head] * LOG2E; l_reg = 1.f; } else { m_reg = -1e30f; l_reg = 0.f; }
    f32x16 o[4] = {};
    f32x16 sbv;
#pragma unroll
    for (int i = 0; i < 16; ++i) sbv[i] = slope2 * (float)((i & 3) + 8 * (i >> 2));
    const float s32 = __builtin_bit_cast(float, __builtin_amdgcn_readfirstlane(__builtin_bit_cast(int, slope2 * 32.0f)));
    const unsigned vb0 = (unsigned)(size_t)(lds + OFF_V) + (unsigned)v_rd_base(lane);
    unsigned ka[4];
#pragma unroll
    for (int dd = 0; dd < 4; ++dd) ka[dd] = (unsigned)(size_t)(lds + OFF_K) + (unsigned)ATT_KSWZ(r32, dd * 32 + hi * 16);
#define ATT_LDK(dst, dd, off) asm volatile("ds_read_b128 %0, %1 offset:%2" : "=&v"(dst) : "v"(kt[dd]), "i"(off) : "memory")
#define ATT_LDK4(x0, x1, x2, x3, d0) do { ATT_LDK(x0, (d0) & 3, ((d0) >> 2) * 128); ATT_LDK(x1, (d0) & 3, ((d0) >> 2) * 128 + 8192); \
        ATT_LDK(x2, ((d0) + 1) & 3, (((d0) + 1) >> 2) * 128); ATT_LDK(x3, ((d0) + 1) & 3, (((d0) + 1) >> 2) * 128 + 8192); } while (0)
#define ATT_WAITK(n, x0, x1, x2, x3) asm volatile("s_waitcnt lgkmcnt(" #n ")" : "+v"(x0), "+v"(x1), "+v"(x2), "+v"(x3) :: "memory")
#define ATT_MM4(P0, P1, x0, x1, x2, x3, d0) do { P0 = __builtin_amdgcn_mfma_f32_32x32x16_bf16(x0, qr[d0], P0, 0, 0, 0); P1 = __builtin_amdgcn_mfma_f32_32x32x16_bf16(x1, qr[d0], P1, 0, 0, 0); \
        P0 = __builtin_amdgcn_mfma_f32_32x32x16_bf16(x2, qr[(d0) + 1], P0, 0, 0, 0); P1 = __builtin_amdgcn_mfma_f32_32x32x16_bf16(x3, qr[(d0) + 1], P1, 0, 0, 0); } while (0)
#define ATT_QK(P0, P1, bo) do { P0 = sbv; P1 = sbv; if (VAR & 2) { P0[0] = (float)(bo); break; } bf16x8 a0_, a1_, a2_, a3_, c0_, c1_, c2_, c3_; unsigned kt[4]; \
        _Pragma("unroll") for (int dd = 0; dd < 4; ++dd) kt[dd] = ka[dd] + (unsigned)(bo); \
        ATT_LDK4(a0_, a1_, a2_, a3_, 0); ATT_LDK4(c0_, c1_, c2_, c3_, 2); ATT_WAITK(4, a0_, a1_, a2_, a3_); ATT_MM4(P0, P1, a0_, a1_, a2_, a3_, 0); \
        ATT_LDK4(a0_, a1_, a2_, a3_, 4); ATT_WAITK(4, c0_, c1_, c2_, c3_); ATT_MM4(P0, P1, c0_, c1_, c2_, c3_, 2); \
        ATT_LDK4(c0_, c1_, c2_, c3_, 6); ATT_WAITK(4, a0_, a1_, a2_, a3_); ATT_MM4(P0, P1, a0_, a1_, a2_, a3_, 4); \
        ATT_WAITK(0, c0_, c1_, c2_, c3_); ATT_MM4(P0, P1, c0_, c1_, c2_, c3_, 6); } while (0)
#define ATT_START_SM(P0, P1, t, al) do { if (VAR & 4) { al = 1.f; break; } const int kbase_ = (j_lo + (t)) * 64; const int dq_ = kbase_ + 4 * hi - tq;     \
        float basef_ = slope2 * (float)dq_; bool emask_; unsigned W_; \
        if (MODE == 0) { emask_ = true; W_ = 128u; } \
        else { const int n_ = kbase_ >> 8; if (n_ < own_blk) { emask_ = false; W_ = 0u; if (((selmask >> n_) & 1u) == 0u) basef_ = NEG; } else { emask_ = true; W_ = 0x40000000u; } } \
        if (emask_) { _Pragma("unroll") for (int r = 0; r < 16; ++r) { const int c_ = (r & 3) + 8 * (r >> 2); \
            if ((unsigned)(-dq_ - c_) >= W_) P0[r] = NEG; if ((unsigned)(-dq_ - c_ - 32) >= W_) P1[r] = NEG; } } \
        float pm0_ = P0[0], pm1_ = P1[0]; \
        _Pragma("unroll") for (int r = 1; r < 16; ++r) { pm0_ = fmaxf(pm0_, P0[r]); pm1_ = fmaxf(pm1_, P1[r]); } \
        float pmax_ = fmaxf(pm0_, pm1_ + s32) + basef_;                       \
        { auto rr_ = __builtin_amdgcn_permlane32_swap(__float_as_uint(pmax_), __float_as_uint(pmax_), false, false); pmax_ = fmaxf(__uint_as_float(rr_[0]), __uint_as_float(rr_[1])); } \
        float mn_; \
        if (__all((pmax_ - m_reg) <= THR)) { mn_ = m_reg; al = 1.f; } else { mn_ = fmaxf(m_reg, pmax_); al = (MODE != 0 && m_reg == -1e30f) ? 1.f : __builtin_amdgcn_exp2f(m_reg - mn_); m_reg = mn_; }     \
        const float off0_ = basef_ - mn_, off1_ = off0_ + s32; \
        _Pragma("unroll") for (int r = 0; r < 16; ++r) { P0[r] = __builtin_amdgcn_exp2f(P0[r] + off0_); P1[r] = P1[r] + off1_; } } while (0)
#define ATT_PK4(P, B_, OUT) do { const unsigned a0_ = cvtpk(P[B_+0], P[B_+1]), a1_ = cvtpk(P[B_+2], P[B_+3]), b0_ = cvtpk(P[B_+4], P[B_+5]), b1_ = cvtpk(P[B_+6], P[B_+7]); \
        auto r0_ = __builtin_amdgcn_permlane32_swap(a0_, b0_, false, false); auto r1_ = __builtin_amdgcn_permlane32_swap(a1_, b1_, false, false); \
        u32x4 w_ = {r0_[0], r1_[0], r0_[1], r1_[1]}; OUT = __builtin_bit_cast(bf16x8, w_); } while (0)
#define ATT_FINISH_SM(P0, P1, al) do { if (VAR & 4) { l_reg += P0[0]; ATT_PK4(P0, 0, pa0); ATT_PK4(P0, 8, pa1); ATT_PK4(P1, 0, pa2); ATT_PK4(P1, 8, pa3); break; } _Pragma("unroll") for (int r = 0; r < 16; ++r) P1[r] = __builtin_amdgcn_exp2f(P1[r]); \
        float ps_ = 0.f; _Pragma("unroll") for (int r = 0; r < 16; ++r) ps_ += P0[r]; _Pragma("unroll") for (int r = 0; r < 16; ++r) ps_ += P1[r]; \
        { auto rr_ = __builtin_amdgcn_permlane32_swap(__float_as_uint(ps_), __float_as_uint(ps_), false, false); ps_ = __uint_as_float(rr_[0]) + __uint_as_float(rr_[1]); } \
        l_reg = l_reg * (al) + ps_; ATT_PK4(P0, 0, pa0); ATT_PK4(P0, 8, pa1); ATT_PK4(P1, 0, pa2); ATT_PK4(P1, 8, pa3); } while (0)
#define ATT_RESC(al) do { if (__any((al) < 1.f)) { if (hi == 0) al_l[r32] = (al); asm volatile("s_waitcnt lgkmcnt(0)" ::: "memory"); float av_[16]; \
        _Pragma("unroll") for (int r = 0; r < 16; ++r) av_[r] = al_l[crow(r, hi)]; \
        _Pragma("unroll") for (int d = 0; d < 4; ++d) _Pragma("unroll") for (int r = 0; r < 16; ++r) o[d][r] *= av_[r]; \
        asm volatile("s_waitcnt lgkmcnt(0)" ::: "memory"); } } while (0)
    f32x16 pX0, pX1, pY0, pY1; float alX = 1.f, alY = 1.f; bf16x8 pa0, pa1, pa2, pa3;
    __syncthreads();
    ATT_QK(pY0, pY1, 0);
    ATT_START_SM(pY0, pY1, 0, alY);
    __syncthreads();
    if (NT > 1) ATT_DMA_V(1, SHM_T);
    ATT_RESC(alY);
#pragma unroll 1
    for (int t = 1; t < NT; ++t) {
        const int bo = (t & 1) * SHM_T, bp = SHM_T - bo;
        if (t + 1 < NT) ATT_DMA_K(t + 1, bp);
        ATT_QK(pX0, pX1, bo);
        ATT_FINISH_SM(pY0, pY1, alY);
        if (!(VAR & 1)) pv_tile(o, vb0 + (unsigned)bp, pa0, pa1, pa2, pa3);
        ATT_START_SM(pX0, pX1, t, alX);
        __syncthreads();
        if (t + 1 < NT) ATT_DMA_V(t + 1, bp);
        ATT_RESC(alX);
        pY0 = pX0; pY1 = pX1; alY = alX;
    }
    ATT_FINISH_SM(pY0, pY1, alY); if (!(VAR & 1)) pv_tile(o, vb0 + (unsigned)(((NT - 1) & 1) * SHM_T), pa0, pa1, pa2, pa3);
#undef ATT_DMA_K
#undef ATT_DMA_V
#undef ATT_LDK
#undef ATT_LDK4
#undef ATT_WAITK
#undef ATT_MM4
#undef ATT_QK
#undef ATT_START_SM
#undef ATT_PK4
#undef ATT_FINISH_SM
#undef ATT_RESC
    if (hi == 0) li_l[r32] = l_reg; asm volatile("s_waitcnt lgkmcnt(0)" ::: "memory");
    float rli[16];
#pragma unroll
    for (int r = 0; r < 16; ++r) rli[r] = __builtin_amdgcn_rcpf(li_l[crow(r, hi)]);
    bf16* Ow = O + (rowbase + tw0) * OPITCH + ocol;
    const bool odd = (r32 & 1) != 0;
#pragma unroll
    for (int r = 0; r < 16; ++r) { const int orow = crow(r, hi);
#pragma unroll
        for (int dp = 0; dp < 2; ++dp) { const float va = o[2 * dp][r] * rli[r], vb = o[2 * dp + 1][r] * rli[r];
            const float send = odd ? va : vb;
            const float recv = __builtin_bit_cast(float, __builtin_amdgcn_mov_dpp(__builtin_bit_cast(int, send), 0xB1, 0xf, 0xf, true));
            const float lo = odd ? recv : va, hi_ = odd ? vb : recv;
            *(unsigned*)(Ow + (size_t)orow * OPITCH + (2 * dp + (odd ? 1 : 0)) * 32 + (r32 & ~1)) = cvtpk(lo, hi_); } }
    __syncthreads();
}
}

#ifndef MK_N_LAUNCHES
#define MK_N_LAUNCHES 1
#endif
#ifndef PROBE_DUP
#define PROBE_DUP 0
#endif
#ifndef PROBE_PK
#define PROBE_PK 2048
#endif
#ifndef FFN1_I8
#define FFN1_I8 1
#endif
#ifndef FFN2_I8
#define FFN2_I8 1
#endif
#ifndef WOUT_I8
#define WOUT_I8 1
#endif
constexpr bool F1Q = FFN1_I8 != 0, F2Q = FFN2_I8 != 0, WOQ = WOUT_I8 != 0;
constexpr int N_PHASES = 16;
constexpr int N_LAUNCHES = MK_N_LAUNCHES;
constexpr int NWAVES = 8;
constexpr int D = 4096, NBATCH = 4, SEQ = 4096, M = NBATCH * SEQ, FF = 11008, DIN = 5632, NMODV = 9 * D  ;
constexpr int CSUB = 4;
constexpr float CSAFE = 1.25f;
#ifndef FILL_A
#define FILL_A 8
#endif
#ifndef FILL_B
#define FILL_B 10
#endif
#ifndef FILL_C
#define FILL_C 8
#endif
constexpr int FILLA = FILL_A, FILLB = FILL_B, FILLC = FILL_C;
constexpr int KS_ADA = 16;
constexpr float EPS = 1e-6f;

constexpr size_t MiB = 1u << 20;
constexpr size_t WS_CTL = 0, CTL_ZERO_BYTES = 1 * MiB;
constexpr size_t WS_MOD = 1 * MiB;
constexpr size_t WS_RSH = 1 * MiB + 768 * 1024;
constexpr size_t WS_RSA = 1 * MiB + 896 * 1024;
constexpr size_t WS_MODP = 2 * MiB;
constexpr size_t WS_KMEAN = 11 * MiB;
constexpr size_t WS_WGU1 = 12 * MiB;
constexpr size_t WS_WD1 = 184 * MiB;
constexpr size_t WS_WGU2 = 270 * MiB;
constexpr size_t WS_WD2 = 442 * MiB;
constexpr size_t WS_WIN = 528 * MiB;
constexpr size_t WS_WOUT = 572 * MiB;
constexpr size_t WS_H = 604 * MiB;
constexpr size_t WS_ACT = 732 * MiB;
constexpr size_t WS_Y = 1076 * MiB;
constexpr size_t WS_PROJ = 1204 * MiB;
constexpr size_t WS_O = 1380 * MiB;
constexpr size_t WS_ACT8 = 1508 * MiB;
constexpr size_t WS_XR = 1680 * MiB;
constexpr size_t WS_END = 1808 * MiB;
static_assert(WS_WGU1 + (size_t)2 * FF * D * 2 <= WS_WD1 && WS_WD1 + (size_t)D * FF * 2 <= WS_WGU2 && WS_WGU2 + (size_t)2 * FF * D * 2 <= WS_WD2 && WS_WD2 + (size_t)D * FF * 2 <= WS_WIN, "ws map 1");
static_assert(WS_WIN + (size_t)DIN * D * 2 <= WS_WOUT && WS_WOUT + (size_t)D * D * 2 <= WS_H && WS_H + (size_t)M * D * 2 <= WS_ACT && WS_ACT + (size_t)M * FF * 2 <= WS_Y, "ws map 2");
static_assert(WS_Y + (size_t)M * D * 2 <= WS_PROJ && WS_PROJ + (size_t)M * DIN * 2 <= WS_O && WS_O + (size_t)M * D * 2 <= WS_ACT8 && WS_ACT8 + (size_t)M * FF <= WS_XR && WS_XR + (size_t)M * D * 2 <= WS_END && WS_MODP + (size_t)KS_ADA * 4 * NMODV * 4 <= WS_KMEAN, "ws map 3");
static_assert(WS_MOD + (size_t)4 * NMODV * 4 <= WS_RSH && WS_RSH + (size_t)M * 4 <= WS_RSA && WS_RSA + (size_t)M * 4 <= WS_MODP, "ws map 4");
constexpr int CW_BAR = 4096;
constexpr int CW_ROWMAX2 = 16384, CW_ROWMAX1 = 32768;
constexpr int CW_CMAX2 = 65536, CW_CMAX1 = 98304;
constexpr int CMAX_DN = 22528;
#ifndef I8MASK_
#define I8MASK_ 0x3FFu
#endif
constexpr unsigned I8MASK = I8MASK_, BFMASK = ~I8MASK_ & 0x3FFFFFu;
constexpr int NT8 = __builtin_popcount(I8MASK), NI8 = 256 * NT8, NBF = DIN - NI8;
static_assert((I8MASK & ~0x3FFFFFu) == 0 && (I8MASK & 0x0FFC00u) == 0 && NT8 >= 1 && NT8 <= 21, "projection split");
constexpr int CW_CMAXI = 131072;
static_assert((size_t)(CW_CMAXI + NI8) * 4 <= CTL_ZERO_BYTES && CW_CMAX1 + CMAX_DN + D <= CW_CMAXI, "control map (projection)");
constexpr int CW_CMAXO = CW_CMAX2 + CMAX_DN + 4096;
static_assert(CW_BAR + 3456 <= CW_ROWMAX2 && CW_ROWMAX2 + M <= CW_ROWMAX1 && CW_ROWMAX1 + M <= CW_CMAX2 && 2 * FF <= CMAX_DN && CW_CMAXO + D <= CW_CMAX1 && (size_t)(CW_CMAX1 + CMAX_DN + D) * 4 <= CTL_ZERO_BYTES, "control map");

constexpr int WAVE_SCR = 64 * 65 * 4;
constexpr int LDSCTL_OFF = 135168, LDS_BYTES = 147456;
static_assert(NWAVES * WAVE_SCR <= LDSCTL_OFF && pg8::STAGE_BYTES <= LDSCTL_OFF && att::ATT_LDS <= LDSCTL_OFF, "LDS map");

#define GAS __attribute__((address_space(1)))
#define LAS __attribute__((address_space(3)))
typedef unsigned short bf16;
typedef unsigned v4u __attribute__((ext_vector_type(4)));
typedef unsigned v2u __attribute__((ext_vector_type(2)));
typedef float f32x4 __attribute__((ext_vector_type(4)));
#define LDS_WAIT() asm volatile("s_waitcnt lgkmcnt(0)" ::: "memory")
__device__ __forceinline__ unsigned pk2(float lo, float hi) { return pg8::cvt_pk_bf16(lo, hi); }
__device__ __forceinline__ float bf_lo(unsigned u) { return __uint_as_float(u << 16); }
__device__ __forceinline__ float bf_hi(unsigned u) { return __uint_as_float(u & 0xffff0000u); }

#define XB_TMO      128
#define XB_XCNT(j)  (256  + 64 * (j))
#define XB_XSUB(j)  (1280 + 64 * (j))
#define XB_XGEN(j)  (2304 + 64 * (j))
#define XB_TOP      3328
#define XB_TOPGEN   3392
#define XCD_BAR_WORDS 3456
#define XB_SPIN_CAP (1u << 18)

__device__ __forceinline__ unsigned xb_ld(unsigned* p)              { return __hip_atomic_load(p, __ATOMIC_RELAXED, __HIP_MEMORY_SCOPE_AGENT); }
__device__ __forceinline__ unsigned xb_add(unsigned* p, unsigned v) { return __hip_atomic_fetch_add(p, v, __ATOMIC_RELAXED, __HIP_MEMORY_SCOPE_AGENT); }
__device__ __forceinline__ unsigned xb_xcc_id() { return (unsigned)__builtin_amdgcn_s_getreg((3 << 11) | 20) & 0xFu; }
#define XB_SPIN(cond, bar) do { unsigned _sp = 0; while (cond) { __builtin_amdgcn_s_sleep(1); \
    if ((++_sp & 255u) == 0u) { if (xb_ld(&(bar)[XB_TMO])) break; if (_sp > XB_SPIN_CAP) { atomicAdd(&(bar)[XB_TMO], 1u); break; } } } } while (0)

struct XcdBarrier {
    unsigned* bar; unsigned x;
    volatile LAS unsigned* st;
};

__device__ __forceinline__ XcdBarrier xcd_barrier_post(unsigned* bar, volatile LAS unsigned* st) {
    XcdBarrier b; b.bar = bar; b.x = xb_xcc_id(); b.st = st;
    if (threadIdx.x == 0) (void)xb_add(&bar[XB_XCNT(b.x)], 1u);
    return b;
}
__device__ __forceinline__ void xcd_barrier_complete(unsigned* bar, unsigned x, unsigned& nloc, unsigned& nx) {
    const unsigned G = gridDim.x * gridDim.y * gridDim.z;
    unsigned sum, cnt, mine, sp = 0u;
    for (;;) {
        sum = 0u; cnt = 0u; mine = 0u;
#pragma unroll
        for (unsigned j = 0; j < 16; ++j) { const unsigned c = xb_ld(&bar[XB_XCNT(j)]); sum += c; cnt += (c > 0u) ? 1u : 0u; mine = (j == x) ? c : mine; }
        if (sum == G) break;
        __builtin_amdgcn_s_sleep(1);
        if ((++sp & 255u) == 0u) { if (xb_ld(&bar[XB_TMO])) break; if (sp > XB_SPIN_CAP) { atomicAdd(&bar[XB_TMO], 1u); break; } }
    }
    nloc = mine > 0u ? mine : 1u; nx = cnt > 0u ? cnt : 1u;
}

__device__ __forceinline__ void xcd_barrier(const XcdBarrier& b) {
    asm volatile("s_waitcnt vmcnt(0)" ::: "memory");
    __syncthreads();
    if (threadIdx.x == 0) {
        unsigned* bar = b.bar;
        __builtin_amdgcn_s_waitcnt(0);
        unsigned nloc = b.st[0], nx = b.st[1];
        if (nloc == 0u) { xcd_barrier_complete(bar, b.x, nloc, nx); b.st[0] = nloc; b.st[1] = nx; }
        const unsigned old = xb_add(&bar[XB_XSUB(b.x)], 1u);
        const unsigned gen = old / nloc;
        if (old + 1u == (gen + 1u) * nloc) {
            __builtin_amdgcn_fence(__ATOMIC_RELEASE, "agent");
            asm volatile("s_waitcnt vmcnt(0)" ::: "memory");
            const unsigned og = xb_add(&bar[XB_TOP], 1u);
            const unsigned tg = og / nx;
            if (og + 1u == (tg + 1u) * nx) xb_add(&bar[XB_TOPGEN], 1u);
            else XB_SPIN(xb_ld(&bar[XB_TOPGEN]) == tg, bar);
            __builtin_amdgcn_fence(__ATOMIC_ACQUIRE, "agent");
            xb_add(&bar[XB_XGEN(b.x)], 1u);
            asm volatile("s_waitcnt vmcnt(0)" ::: "memory");
        } else {
            XB_SPIN(xb_ld(&bar[XB_XGEN(b.x)]) == gen, bar);
            __builtin_amdgcn_fence(__ATOMIC_ACQUIRE, "agent");
            asm volatile("s_waitcnt vmcnt(0)" ::: "memory");
        }
    }
    __syncthreads();
}


template <int CTRL> __device__ __forceinline__ float dpp_mov(float v) { return __builtin_bit_cast(float, __builtin_amdgcn_mov_dpp(__builtin_bit_cast(int, v), CTRL, 0xf, 0xf, true)); }
__device__ __forceinline__ float wave_sum(float v) {
    v += dpp_mov<0xB1>(v); v += dpp_mov<0x4E>(v); v += dpp_mov<0x141>(v); v += dpp_mov<0x140>(v);
    { auto r = __builtin_amdgcn_permlane16_swap(__float_as_uint(v), __float_as_uint(v), false, false); v = __uint_as_float(r[0]) + __uint_as_float(r[1]); }
    { auto r = __builtin_amdgcn_permlane32_swap(__float_as_uint(v), __float_as_uint(v), false, false); v = __uint_as_float(r[0]) + __uint_as_float(r[1]); }
    return v;
}

__device__ __forceinline__ int dest_row(int n, int mode) { return mode == 0 ? n : ((n >> 7) * 256 + (n & 127) + (mode == 2 ? 128 : 0)); }
__device__ __forceinline__ void p0_tr_item(const float* W, int K, int N, bf16* WT, int item, int mode, const float* kscale, LAS float* scr, int lane, int NC = 0) {
    const int nblk = (NC ? NC : N) >> 6, kb = item / nblk, nb = item - kb * nblk, k0 = kb << 6, n0 = nb << 6;
    const float* src = W + (size_t)k0 * N + n0 + lane;
    if (kscale) { const float ks = kscale[k0 + lane];
#pragma unroll 16
        for (int i = 0; i < 64; ++i) scr[i * 65 + lane] = src[(size_t)i * N] * __builtin_bit_cast(float, __builtin_amdgcn_readlane(__builtin_bit_cast(int, ks), i));
    } else {
#pragma unroll 16
        for (int i = 0; i < 64; ++i) scr[i * 65 + lane] = src[(size_t)i * N];
    }
    LDS_WAIT();
    const int c = lane & 7, drow0 = dest_row(n0, mode);
#pragma unroll
    for (int j = 0; j < 8; ++j) { const int n = (lane >> 3) + 8 * j; const LAS float* s = scr + (8 * c) * 65 + n;
        v4u o; o.x = pk2(s[0 * 65], s[1 * 65]); o.y = pk2(s[2 * 65], s[3 * 65]); o.z = pk2(s[4 * 65], s[5 * 65]); o.w = pk2(s[6 * 65], s[7 * 65]);
        *(v4u*)(WT + (size_t)(drow0 + n) * K + k0 + 8 * c) = o; }
    LDS_WAIT();
}
__device__ __forceinline__ void p0_cmax_item(const float* W, int K, int N, unsigned* cmax, int item, int mode, const float* kscale, int lane, int NC = 0) {
    const int nblk = (NC ? NC : N) >> 8, kb = (item / nblk) * CSUB + (CSUB > 1 ? 1 : 0), nb = item % nblk, k0 = kb << 6, n0 = (nb << 8) + 4 * lane;
    const float* src = W + (size_t)k0 * N + n0;
    f32x4 m = (f32x4){0.f, 0.f, 0.f, 0.f};
    if (kscale) {
        const float ks = fabsf(kscale[k0 + lane]);
#pragma unroll 16
        for (int i = 0; i < 64; ++i) { const f32x4 v = __builtin_nontemporal_load((const f32x4*)(src + (size_t)i * N));
            const float s = __builtin_bit_cast(float, __builtin_amdgcn_readlane(__builtin_bit_cast(int, ks), i)); m = __builtin_elementwise_max(m, __builtin_elementwise_abs(v) * s); }
    } else {
#pragma unroll 16
        for (int i = 0; i < 64; ++i) { const f32x4 v = __builtin_nontemporal_load((const f32x4*)(src + (size_t)i * N)); m = __builtin_elementwise_max(m, __builtin_elementwise_abs(v)); }
    }
    const int d = dest_row(n0, mode);
#pragma unroll
    for (int e = 0; e < 4; ++e) atomicMax(cmax + d + e, __float_as_uint(m[e] * CSAFE));
}
constexpr float Q8_MAGIC = 12582912.0f;
__device__ __forceinline__ unsigned q8pack(float a, float b, float c, float d) {
    const unsigned ua = __float_as_uint(a + Q8_MAGIC), ub = __float_as_uint(b + Q8_MAGIC), uc = __float_as_uint(c + Q8_MAGIC), ud = __float_as_uint(d + Q8_MAGIC);
    const unsigned lo = __builtin_amdgcn_perm(ub, ua, 0x0c0c0400u), hi = __builtin_amdgcn_perm(ud, uc, 0x0c0c0400u);
    return __builtin_amdgcn_perm(hi, lo, 0x05040100u);
}
__device__ __forceinline__ void p0_q8_item(const float* W, int K, int N, signed char* WQ, const unsigned* cmax, int item, int mode, const float* kscale, LAS float* scr, int lane) {
    const int nblk = N >> 6, kb = item / nblk, nb = item - kb * nblk, k0 = kb << 6, n0 = nb << 6;
    const float* src = W + (size_t)k0 * N + n0 + lane;
#pragma unroll 16
    for (int i = 0; i < 64; ++i) { float v = src[(size_t)i * N]; if (kscale) v *= kscale[k0 + i]; scr[i * 65 + lane] = v; }
    LDS_WAIT();
    const int c = lane & 3, drow0 = dest_row(n0, mode);
#pragma unroll
    for (int j = 0; j < 4; ++j) { const int n = (lane >> 2) + 16 * j; const LAS float* s = scr + (16 * c) * 65 + n;
        const float amax = __uint_as_float(cmax[drow0 + n]), inv = amax > 0.f ? 127.0f / amax : 0.f;
        v4u o;
#pragma unroll
        for (int q = 0; q < 4; ++q) o[q] = q8pack(fminf(fmaxf(s[(4 * q + 0) * 65] * inv, -127.f), 127.f), fminf(fmaxf(s[(4 * q + 1) * 65] * inv, -127.f), 127.f), fminf(fmaxf(s[(4 * q + 2) * 65] * inv, -127.f), 127.f), fminf(fmaxf(s[(4 * q + 3) * 65] * inv, -127.f), 127.f));
        *(v4u*)(WQ + (size_t)(drow0 + n) * K + k0 + 16 * c) = o; }
    LDS_WAIT();
}
constexpr int QT_S = 132;
struct Q8P { const float* W; int K, N; signed char* WQ; const unsigned* cmax; int item, mode; const float* kscale; int NC; };
__device__ __forceinline__ void q8_ld(const Q8P q, int wave, int lane, f32x4 (&v)[8], float (&amx)[2], float (&ks)[8]) {
    const int nblk = (q.NC ? q.NC : q.N) >> 7, kb = q.item / nblk, nb = q.item - kb * nblk, k0 = kb << 7, n0 = nb << 7;
    const int r0 = 16 * wave + (lane >> 5), c0 = 4 * (lane & 31);
    const float* src = q.W + (size_t)(k0 + r0) * q.N + n0 + c0;
#pragma unroll
    for (int jj = 0; jj < 2; ++jj) amx[jj] = __uint_as_float(q.cmax[dest_row(n0 + 16 * wave + (lane >> 3) + 8 * jj, q.mode)]);
#pragma unroll
    for (int i = 0; i < 8; ++i) v[i] = __builtin_nontemporal_load((const f32x4*)(src + (size_t)(2 * i) * q.N));
    if (q.kscale) {
#pragma unroll
        for (int i = 0; i < 8; ++i) ks[i] = q.kscale[k0 + r0 + 2 * i]; }
}
__device__ __forceinline__ void q8_to_lds(const Q8P q, const f32x4 (&v)[8], const float (&ks)[8], LAS float* T, int wave, int lane) {
    const int r0 = 16 * wave + (lane >> 5), c0 = 4 * (lane & 31);
    if (q.kscale) {
#pragma unroll
        for (int i = 0; i < 8; ++i) *(LAS f32x4*)(T + (r0 + 2 * i) * QT_S + c0) = v[i] * ks[i]; }
    else {
#pragma unroll
        for (int i = 0; i < 8; ++i) *(LAS f32x4*)(T + (r0 + 2 * i) * QT_S + c0) = v[i]; }
}
__device__ __forceinline__ void q8_quant(const Q8P q, const float (&amx)[2], const LAS float* T, int wave, int lane) {
    const int nblk = (q.NC ? q.NC : q.N) >> 7, kb = q.item / nblk, nb = q.item - kb * nblk, k0 = kb << 7, n0 = nb << 7;
    const int c = lane & 7;
#pragma unroll
    for (int jj = 0; jj < 2; ++jj) { const int n = 16 * wave + (lane >> 3) + 8 * jj, d = dest_row(n0 + n, q.mode); const LAS float* s = T + (16 * c) * QT_S + n;
        const float amax = amx[jj], inv = amax > 0.f ? 127.0f * __builtin_amdgcn_rcpf(amax) : 0.f;
        v4u o;
#pragma unroll
        for (int qq = 0; qq < 4; ++qq) o[qq] = q8pack(fminf(fmaxf(s[(4 * qq + 0) * QT_S] * inv, -127.f), 127.f), fminf(fmaxf(s[(4 * qq + 1) * QT_S] * inv, -127.f), 127.f),
                                                    fminf(fmaxf(s[(4 * qq + 2) * QT_S] * inv, -127.f), 127.f), fminf(fmaxf(s[(4 * qq + 3) * QT_S] * inv, -127.f), 127.f));
        *(v4u*)(q.WQ + (size_t)d * q.K + k0 + 16 * c) = o; }
}
__device__ __forceinline__ void wg_q8_item(const Q8P q, LAS float* T, int wave, int lane) {
    f32x4 v[8]; float amx[2], ks[8];
    q8_ld(q, wave, lane, v, amx, ks); q8_to_lds(q, v, ks, T, wave, lane);
    __syncthreads();
    q8_quant(q, amx, T, wave, lane);
    __syncthreads();
}
__device__ __forceinline__ void wg_q8_item2(const Q8P qa, const Q8P qb, LAS float* T, int wave, int lane) {
    f32x4 va[8], vb[8]; float aa[2], ab[2], ka[8], kb[8];
    q8_ld(qa, wave, lane, va, aa, ka); q8_ld(qb, wave, lane, vb, ab, kb);
    __builtin_amdgcn_sched_barrier(0);
    q8_to_lds(qa, va, ka, T, wave, lane); q8_to_lds(qb, vb, kb, T + 128 * QT_S, wave, lane);
    __syncthreads();
    q8_quant(qa, aa, T, wave, lane); q8_quant(qb, ab, T + 128 * QT_S, wave, lane);
    __syncthreads();
}
static_assert(2 * 128 * QT_S * 4 <= LDSCTL_OFF, "two weight-copy tiles in LDS");
__device__ __forceinline__ void p0_gemv_item(const float* cvec, const float* Wada, float* modp, int item, LAS float* scr, int lane) {
    const int cc = item % (NMODV / 256), ks = item / (NMODV / 256), k0 = ks * 256, col = cc * 256 + 4 * lane;
#pragma unroll
    for (int b = 0; b < 4; ++b) { f32x4 v = *(const f32x4*)(cvec + b * D + k0 + 4 * lane);
#pragma unroll
        for (int e = 0; e < 4; ++e) v[e] = v[e] / (1.0f + __expf(-v[e]));
        *(LAS f32x4*)(scr + b * 256 + 4 * lane) = v; }
    LDS_WAIT();
    f32x4 acc[4];
#pragma unroll
    for (int b = 0; b < 4; ++b) acc[b] = (f32x4){0.f, 0.f, 0.f, 0.f};
    const float* wp = Wada + (size_t)k0 * NMODV + col;
#pragma unroll 2
    for (int k4 = 0; k4 < 64; ++k4) {
        const f32x4 w0 = __builtin_nontemporal_load((const f32x4*)(wp + (size_t)(4 * k4 + 0) * NMODV)), w1 = __builtin_nontemporal_load((const f32x4*)(wp + (size_t)(4 * k4 + 1) * NMODV));
        const f32x4 w2 = __builtin_nontemporal_load((const f32x4*)(wp + (size_t)(4 * k4 + 2) * NMODV)), w3 = __builtin_nontemporal_load((const f32x4*)(wp + (size_t)(4 * k4 + 3) * NMODV));
#pragma unroll
        for (int b = 0; b < 4; ++b) { const f32x4 s = *(const LAS f32x4*)(scr + b * 256 + 4 * k4);
            acc[b] += s[0] * w0; acc[b] += s[1] * w1; acc[b] += s[2] * w2; acc[b] += s[3] * w3; }
    }
#pragma unroll
    for (int b = 0; b < 4; ++b) *(f32x4*)(modp + ((size_t)(ks * 4 + b)) * NMODV + col) = acc[b];
    LDS_WAIT();
}
__device__ __forceinline__ float mod_reduce(const float* modp, const float* bada, int b, int j) {
    float s = bada[j];
#pragma unroll
    for (int ks = 0; ks < KS_ADA; ++ks) s += modp[((size_t)(ks * 4 + b)) * NMODV + j];
    return s;
}

__device__ __forceinline__ float wave_max(float v) {
    v = fmaxf(v, dpp_mov<0xB1>(v)); v = fmaxf(v, dpp_mov<0x4E>(v)); v = fmaxf(v, dpp_mov<0x141>(v)); v = fmaxf(v, dpp_mov<0x140>(v));
    { auto r = __builtin_amdgcn_permlane16_swap(__float_as_uint(v), __float_as_uint(v), false, false); v = fmaxf(__uint_as_float(r[0]), __uint_as_float(r[1])); }
    { auto r = __builtin_amdgcn_permlane32_swap(__float_as_uint(v), __float_as_uint(v), false, false); v = fmaxf(__uint_as_float(r[0]), __uint_as_float(r[1])); }
    return v;
}
template <int HQ>
__device__ __forceinline__ void store_h(const f32x4 (&v)[16], float rstd, void* hrow, float* rscale, const LAS float* vA, const LAS float* vS, int lane) {
    if (HQ == 0) { GAS v2u* o8 = (GAS v2u*)hrow + lane;
#pragma unroll
        for (int jb = 0; jb < 16; jb += 4) { f32x4 a[4], s[4];
#pragma unroll
            for (int jj = 0; jj < 4; ++jj) { a[jj] = *(const LAS f32x4*)(vA + 256 * (jb + jj) + 4 * lane); s[jj] = *(const LAS f32x4*)(vS + 256 * (jb + jj) + 4 * lane); }
#pragma unroll
            for (int jj = 0; jj < 4; ++jj) { const f32x4 h = v[jb + jj] * rstd * a[jj] + s[jj]; o8[64 * (jb + jj)] = (v2u){pk2(h.x, h.y), pk2(h.z, h.w)}; } } }
    else { float am = 0.f;
#pragma unroll
        for (int jb = 0; jb < 16; jb += 4) { f32x4 a[4], s[4];
#pragma unroll
            for (int jj = 0; jj < 4; ++jj) { a[jj] = *(const LAS f32x4*)(vA + 256 * (jb + jj) + 4 * lane); s[jj] = *(const LAS f32x4*)(vS + 256 * (jb + jj) + 4 * lane); }
#pragma unroll
            for (int jj = 0; jj < 4; ++jj) { const f32x4 h = __builtin_elementwise_abs(v[jb + jj] * rstd * a[jj] + s[jj]); am = fmaxf(am, fmaxf(fmaxf(h.x, h.y), fmaxf(h.z, h.w))); } }
        am = wave_max(am); const float inv = am > 0.f ? 127.0f / am : 0.f;
        asm volatile("" ::: "memory");
        if (lane == 0) *(GAS float*)rscale = am * (1.0f / 127.0f);
        GAS unsigned* o4 = (GAS unsigned*)hrow + lane;
#pragma unroll
        for (int jb = 0; jb < 16; jb += 4) { f32x4 a[4], s[4];
#pragma unroll
            for (int jj = 0; jj < 4; ++jj) { a[jj] = *(const LAS f32x4*)(vA + 256 * (jb + jj) + 4 * lane); s[jj] = *(const LAS f32x4*)(vS + 256 * (jb + jj) + 4 * lane); }
#pragma unroll
            for (int jj = 0; jj < 4; ++jj) { const f32x4 h = (v[jb + jj] * rstd * a[jj] + s[jj]) * inv; o4[64 * (jb + jj)] = q8pack(h.x, h.y, h.z, h.w); } } }
}
template <int HQ>
__device__ __forceinline__ void row_norm_mod(const float* xrow, void* hrow, float* rscale, const LAS float* vA, const LAS float* vS, int lane) {
    const f32x4* xr = (const f32x4*)xrow + lane; f32x4 v[16]; float ss = 0.f;
#pragma unroll
    for (int j = 0; j < 16; ++j) { v[j] = __builtin_nontemporal_load(xr + 64 * j); ss += (v[j].x * v[j].x + v[j].y * v[j].y) + (v[j].z * v[j].z + v[j].w * v[j].w); }
    const float rstd = 1.0f / sqrtf(wave_sum(ss) * (1.0f / D) + EPS);
    store_h<HQ>(v, rstd, hrow, rscale, vA, vS, lane);
}
template <bool NEXT, int HQ, int XS, int OS, int HQ2 = -1>
__device__ __forceinline__ void row_resid(const void* xrow, const unsigned char* yrow, const float* yscr, void* orow, void* hrow, void* hrow2, float* rscale, const LAS float* vG, const LAS float* vA, const LAS float* vS, int lane) {
    const unsigned* y4 = (const unsigned*)yrow + lane; const float* ysr = yscr + (lane >> 3);
    unsigned yq[16]; float ysv[16]; float ss = 0.f;
#pragma unroll
    for (int j = 0; j < 16; ++j) { yq[j] = __builtin_nontemporal_load(y4 + 64 * j); ysv[j] = __builtin_nontemporal_load(ysr + 8 * j); }
    f32x4 xv[XS == 0 ? 16 : 1]; v2u xw[XS == 0 ? 1 : 16];
    if (XS == 0) { const f32x4* xr = (const f32x4*)xrow + lane;
#pragma unroll
        for (int j = 0; j < 16; ++j) xv[j] = __builtin_nontemporal_load(xr + 64 * j); }
    else { const v2u* xr = (const v2u*)xrow + lane;
#pragma unroll
        for (int j = 0; j < 16; ++j) xw[j] = __builtin_nontemporal_load(xr + 64 * j); }
    __builtin_amdgcn_sched_barrier(0);
#pragma unroll
    for (int j = 0; j < 16; ++j) { const float s = ysv[j], o = -128.0f * s; const float a = fmaf((float)(yq[j] & 0xffu), s, o), b = fmaf((float)((yq[j] >> 8) & 0xffu), s, o), c = fmaf((float)((yq[j] >> 16) & 0xffu), s, o), d = fmaf((float)(yq[j] >> 24), s, o); ss += (a * a + b * b) + (c * c + d * d); }
    const float rstd_y = 1.0f / sqrtf(wave_sum(ss) * (1.0f / D) + EPS);
    asm volatile("" ::: "memory");
    f32x4 v[NEXT ? 16 : 1]; float ss1 = 0.f;
#pragma unroll
    for (int jb = 0; jb < 16; jb += 4) { f32x4 g4[4];
#pragma unroll
        for (int jj = 0; jj < 4; ++jj) g4[jj] = *(const LAS f32x4*)(vG + 256 * (jb + jj) + 4 * lane);
#pragma unroll
        for (int jj = 0; jj < 4; ++jj) { const int j = jb + jj; const f32x4 g = g4[jj];
            const float ys_ = ysv[j], yo_ = -128.0f * ys_;
            const f32x4 y = (f32x4){fmaf((float)(yq[j] & 0xffu), ys_, yo_), fmaf((float)((yq[j] >> 8) & 0xffu), ys_, yo_), fmaf((float)((yq[j] >> 16) & 0xffu), ys_, yo_), fmaf((float)(yq[j] >> 24), ys_, yo_)};
            const f32x4 x = XS == 0 ? xv[XS == 0 ? j : 0] : (f32x4){bf_lo(xw[XS == 0 ? 0 : j].x), bf_hi(xw[XS == 0 ? 0 : j].x), bf_lo(xw[XS == 0 ? 0 : j].y), bf_hi(xw[XS == 0 ? 0 : j].y)};
            f32x4 r = x + g * (y * rstd_y);
            if (OS == 0) __builtin_nontemporal_store(r, (GAS f32x4*)orow + lane + 64 * j);
            else { const v2u w = (v2u){pk2(r.x, r.y), pk2(r.z, r.w)}; __builtin_nontemporal_store(w, (GAS v2u*)orow + lane + 64 * j);
                   r = (f32x4){bf_lo(w.x), bf_hi(w.x), bf_lo(w.y), bf_hi(w.y)}; }
            if (NEXT) { v[NEXT ? j : 0] = r; ss1 += (r.x * r.x + r.y * r.y) + (r.z * r.z + r.w * r.w); } } }
    if (NEXT) { const float rstd = 1.0f / sqrtf(wave_sum(ss1) * (1.0f / D) + EPS); store_h<HQ>((const f32x4 (&)[16])v, rstd, hrow, rscale, vA, vS, lane);
        if (HQ2 >= 0) { asm volatile("" ::: "memory"); store_h<(HQ2 >= 0 ? HQ2 : 0)>((const f32x4 (&)[16])v, rstd, hrow2, rscale, vA, vS, lane); } }
}
template <int HQ>
__device__ __forceinline__ void row_groupnorm(const bf16* orow, void* hrow, float* rscale, int lane) {
    const v4u* o16 = (const v4u*)orow + lane; v4u w[8]; float sa = 0.f, sb = 0.f;
#pragma unroll
    for (int j = 0; j < 8; ++j) { w[j] = __builtin_nontemporal_load(o16 + 64 * j); float s = 0.f;
#pragma unroll
        for (int e = 0; e < 4; ++e) { const float a = bf_lo(w[j][e]), c = bf_hi(w[j][e]); s += a * a + c * c; }
        if (j < 4) sa += s; else sb += s; }
    const float ra = 1.0f / sqrtf(wave_sum(sa) * (1.0f / 2048.f) + EPS), rb = 1.0f / sqrtf(wave_sum(sb) * (1.0f / 2048.f) + EPS);
    if (HQ == 0) { v4u* h16 = (v4u*)hrow + lane;
#pragma unroll
        for (int j = 0; j < 8; ++j) { const float r = j < 4 ? ra : rb; v4u o;
#pragma unroll
            for (int e = 0; e < 4; ++e) o[e] = pk2(bf_lo(w[j][e]) * r, bf_hi(w[j][e]) * r);
            h16[64 * j] = o; } }
    else { float am = 0.f;
#pragma unroll
        for (int j = 0; j < 8; ++j) { const float r = j < 4 ? ra : rb;
#pragma unroll
            for (int e = 0; e < 4; ++e) am = fmaxf(am, fmaxf(fabsf(bf_lo(w[j][e]) * r), fabsf(bf_hi(w[j][e]) * r))); }
        am = wave_max(am); const float inv = am > 0.f ? 127.0f / am : 0.f;
        if (lane == 0) *rscale = am * (1.0f / 127.0f);
        v2u* h8 = (v2u*)hrow + lane;
#pragma unroll
        for (int j = 0; j < 8; ++j) { const float r = (j < 4 ? ra : rb) * inv;
            h8[64 * j] = (v2u){q8pack(bf_lo(w[j][0]) * r, bf_hi(w[j][0]) * r, bf_lo(w[j][1]) * r, bf_hi(w[j][1]) * r), q8pack(bf_lo(w[j][2]) * r, bf_hi(w[j][2]) * r, bf_lo(w[j][3]) * r, bf_hi(w[j][3]) * r)}; } }
}
constexpr int NLS = FF / 32;
__device__ __forceinline__ void row_actq(signed char* qrow, const float* lrow, const unsigned* rowmax, float* rsa, int lane) {
    v4u* q16 = (v4u*)qrow; v4u w[11]; float f[11];
#pragma unroll
    for (int j = 0; j < 11; ++j) { const int idx = j * 64 + lane; const bool on = j < 10 || lane < 48;
        w[j] = on ? __builtin_nontemporal_load(q16 + idx) : (v4u){0u, 0u, 0u, 0u}; f[j] = on ? __builtin_nontemporal_load(lrow + (idx >> 1)) : 0.f; }
    const float amax = __uint_as_float(*rowmax), inv = amax > 0.f ? 127.0f / amax : 0.f;
    if (lane == 0) *rsa = amax * (1.0f / 127.0f);
#pragma unroll
    for (int j = 0; j < 11; ++j) { const int idx = j * 64 + lane; const float s = f[j] * inv;
        v4u o;
#pragma unroll
        for (int e = 0; e < 4; ++e) { const unsigned x = w[j][e]; const float o128 = -128.0f * s;
            const float a = fmaf((float)(x & 0xffu), s, o128), b = fmaf((float)((x >> 8) & 0xffu), s, o128), c = fmaf((float)((x >> 16) & 0xffu), s, o128), d = fmaf((float)(x >> 24), s, o128);
            o[e] = q8pack(a, b, c, d); }
        if (j < 10 || lane < 48) q16[idx] = o; }
}
static_assert(FF / 16 == 10 * 64 + 48 && FF % 32 == 0, "row_actq chunking");
#define P0_PARAMS const float* P_c_in, const float* P_w_ada, const float* P_f1_wg, const float* P_f1_wu, const float* P_f1_wd, const float* P_w_in, const float* P_w_out, const float* P_norm_a, const float* P_norm_b, \
        const float* P_f2_wg, const float* P_f2_wu, const float* P_f2_wd, float* P_modp, unsigned char* P_Wgu1, unsigned char* P_Wd1, unsigned char* P_Win, unsigned char* P_Wout, unsigned char* P_Wgu2, unsigned char* P_Wd2, unsigned* P_cmax1, unsigned* P_cmax2, unsigned* P_cmaxo
#define P0_ARGS P_c_in, P_w_ada, P_f1_wg, P_f1_wu, P_f1_wd, P_w_in, P_w_out, P_norm_a, P_norm_b, P_f2_wg, P_f2_wu, P_f2_wd, P_modp, P_Wgu1, P_Wd1, P_Win, P_Wout, P_Wgu2, P_Wd2, P_cmax1, P_cmax2, P_cmaxo
__device__ __forceinline__ void p0_phase(LAS unsigned char* lds, int wave, int lane, int blk, int G, P0_PARAMS) {
    LAS float* scr = (LAS float*)(lds + wave * WAVE_SCR);
    const int gw = blk * NWAVES + wave, NGW = G * NWAVES;
    constexpr int I_T = (D / 64) * (FF / 64)  , I_C = (D / 64 / CSUB) * (FF / 256)  ;
    constexpr int I_1 = F1Q ? I_C : I_T, I_2 = F2Q ? I_C : I_T, I_IN = (D / 64) * (NBF / 64)  , I_CI = (D / 64 / CSUB) * NT8  , I_OUT = WOQ ? (D / 64 / CSUB) * (D / 256) : (D / 64) * (D / 64), I_GV = (NMODV / 256) * KS_ADA;
    constexpr int NITEMS = I_GV + 3 * I_1 + I_IN + I_CI + I_OUT + 3 * I_2;
    static_assert((FF / 64) * (D / 64) == I_T && (FF / 64 / CSUB) * (D / 256) == I_C, "item counts (the down matrix has K = FF, N = D)");
    for (int it = gw; it < NITEMS; it += NGW) {
        int r = it;
        if (r < I_GV) { p0_gemv_item(P_c_in, P_w_ada, P_modp, r, scr, lane); continue; } r -= I_GV;
        if (r < 3 * I_1) { const int w = r / I_1; r -= w * I_1;
            const float* src = w == 0 ? P_f1_wg : (w == 1 ? P_f1_wu : P_f1_wd);
            if (F1Q) p0_cmax_item(src, w == 2 ? FF : D, w == 2 ? D : FF, P_cmax1 + (w == 2 ? CMAX_DN : 0), r, w == 2 ? 0 : w + 1, nullptr, lane);
            else p0_tr_item(src, w == 2 ? FF : D, w == 2 ? D : FF, (bf16*)(w == 2 ? P_Wd1 : P_Wgu1), r, w == 2 ? 0 : w + 1, nullptr, scr, lane);
            continue; } r -= 3 * I_1;
        if (r < I_IN) { const int gt = r / ((D / 64) * 4), sub = r - gt * ((D / 64) * 4);
            p0_tr_item(P_w_in + 256 * pg8::nth_set(BFMASK, gt), D, DIN, (bf16*)P_Win + (size_t)gt * 256 * D, sub, 0, nullptr, scr, lane, 256); continue; } r -= I_IN;
        if (r < I_CI) { const int gt = r / (D / 64 / CSUB), sub = r - gt * (D / 64 / CSUB);
            p0_cmax_item(P_w_in + 256 * pg8::nth_set(I8MASK, gt), D, DIN, P_cmaxo + (CW_CMAXI - CW_CMAXO) + 256 * gt, sub, 0, nullptr, lane, 256); continue; } r -= I_CI;
        if (r < I_OUT) { if (WOQ) { const int kb = (r / (D / 256)) * CSUB; p0_cmax_item(P_w_out, D, D, P_cmaxo, r, 0, (kb < 32 ? P_norm_a : P_norm_b - 2048), lane); }
            else { const int kb = r / (D / 64); p0_tr_item(P_w_out, D, D, (bf16*)P_Wout, r, 0, (kb < 32 ? P_norm_a : P_norm_b - 2048), scr, lane); } continue; } r -= I_OUT;
        { const int w = r / I_2; r -= w * I_2;
            const float* src = w == 0 ? P_f2_wg : (w == 1 ? P_f2_wu : P_f2_wd);
            if (F2Q) p0_cmax_item(src, w == 2 ? FF : D, w == 2 ? D : FF, P_cmax2 + (w == 2 ? CMAX_DN : 0), r, w == 2 ? 0 : w + 1, nullptr, lane);
            else p0_tr_item(src, w == 2 ? FF : D, w == 2 ? D : FF, (bf16*)(w == 2 ? P_Wd2 : P_Wgu2), r, w == 2 ? 0 : w + 1, nullptr, scr, lane); }
    }
}
constexpr int I_W = (D / 128) * (FF / 128);
static_assert((FF / 128) * (D / 128) == I_W, "item counts (the down matrix has K = FF, N = D)");
constexpr int POOL_N = 3 * I_W + (D / 128) * (D / 128);
__device__ __forceinline__ Q8P pool_q8p(int p, P0_PARAMS) {
    if (p < 3 * I_W) { const int w = p / I_W, r = p - w * I_W;
        return Q8P{w == 0 ? P_f2_wg : (w == 1 ? P_f2_wu : P_f2_wd), w == 2 ? FF : D, w == 2 ? D : FF, (signed char*)(w == 2 ? P_Wd2 : P_Wgu2), P_cmax2 + (w == 2 ? CMAX_DN : 0), r, w == 2 ? 0 : w + 1, nullptr}; }
    const int r = p - 3 * I_W, kb = r / (D / 128);
    return Q8P{P_w_out, D, D, (signed char*)P_Wout, P_cmaxo, r, 0, (kb < 16 ? P_norm_a : P_norm_b - 2048)};
}
__device__ __forceinline__ void pool_fill(LAS unsigned char* lds, int wave, int lane, int blk, int G, int first, int base, int per_wg, P0_PARAMS) {
    if (blk < first) return;
    const int nq = G - first, wq = blk - first;
    for (int i = 0; i < per_wg; i += 2) { const int p = base + i * nq + wq, p2 = p + nq;
        if (p >= POOL_N) break;
        if (i + 1 < per_wg && p2 < POOL_N) wg_q8_item2(pool_q8p(p, P0_ARGS), pool_q8p(p2, P0_ARGS), (LAS float*)lds, wave, lane);
        else wg_q8_item(pool_q8p(p, P0_ARGS), (LAS float*)lds, wave, lane); }
}
constexpr int I_WIN = (D / 128) * (NI8 / 128);
constexpr size_t WINA_OFF = (size_t)NBF * D * 2;
constexpr int POOL_C0 = 2 * I_W;
__device__ __forceinline__ Q8P p1_q8p(int it, int fill_n, int rest1, int c_n, P0_PARAMS) {
    if (it >= 3 * I_W && it < 3 * I_W + I_WIN) { const int j = it - 3 * I_W; unsigned* cmi = P_cmaxo + (CW_CMAXI - CW_CMAXO);
        const int gt = j / ((D / 128) * 2), sub = j - gt * ((D / 128) * 2);
        return Q8P{P_w_in + 256 * pg8::nth_set(I8MASK, gt), D, DIN, (signed char*)(P_Win + WINA_OFF) + (size_t)gt * 256 * D, cmi + 256 * gt, sub, 0, nullptr, 256}; }
    if (it >= 3 * I_W + I_WIN) it -= I_WIN;
    if (it < 3 * I_W) { const int w = it / I_W, r = it - w * I_W;
        return Q8P{w == 0 ? P_f1_wg : (w == 1 ? P_f1_wu : P_f1_wd), w == 2 ? FF : D, w == 2 ? D : FF, (signed char*)(w == 2 ? P_Wd1 : P_Wgu1), P_cmax1 + (w == 2 ? CMAX_DN : 0), r, w == 2 ? 0 : w + 1, nullptr}; }
    const int j = it - 3 * I_W;
    return pool_q8p(j < rest1 ? fill_n + j : POOL_C0 + c_n + (j - rest1), P0_ARGS);
}
template <int HQ>
__device__ __forceinline__ void p1_phase(LAS unsigned char* lds, int tid, int wave, int lane, int blk, int G, P0_PARAMS, const float* x_in, const float* b_ada, const float* f1_pre, float* modf, void* Hb, float* rsh) {
    static_assert(F1Q && F2Q && WOQ, "the pool split below is written for the all-int8 configuration");
    {
        const int rem_a = ((M / 256) * (2 * FF / 256)) % G, rem_b = ((M / 256) * (NI8 / 256)) % G;
        const int short_wgs = rem_a ? G - rem_a : 0, short_wgs_b = rem_b ? G - rem_b : 0;
        const int fill_n = FILLA * short_wgs + FILLB * short_wgs_b;
        const bool c_ok = fill_n <= POOL_C0 && FILLC * short_wgs <= I_W;
        const int c_n = c_ok ? FILLC * short_wgs : 0, rest1 = c_ok ? POOL_C0 - fill_n : (POOL_N > fill_n ? POOL_N - fill_n : 0), rest2 = c_ok ? POOL_N - (POOL_C0 + c_n) : 0;
        const int NQ = 3 * I_W + I_WIN + rest1 + rest2;
        for (int it = blk; it < NQ; it += 2 * G) { const int it2 = it + G;
            if (it2 < NQ) wg_q8_item2(p1_q8p(it, fill_n, rest1, c_n, P0_ARGS), p1_q8p(it2, fill_n, rest1, c_n, P0_ARGS), (LAS float*)lds, wave, lane);
            else wg_q8_item(p1_q8p(it, fill_n, rest1, c_n, P0_ARGS), (LAS float*)lds, wave, lane);
        }
    }
    const float* modp = P_modp;
    for (int j = blk * (NWAVES * 64) + tid; j < 4 * NMODV; j += G * NWAVES * 64) { const int b = j / NMODV, jj = j - b * NMODV; modf[j] = mod_reduce(modp, b_ada, b, jj); }
    LAS float* vA = (LAS float*)lds; LAS float* vS = vA + D;
    int cur_b = -1;
    for (int ch = blk; ch < M / 64; ch += G) {
        const int b = ch / (SEQ / 64);
        if (b != cur_b) { __syncthreads();
            for (int k = tid; k < D; k += NWAVES * 64) { vA[k] = f1_pre[k] * (1.0f + mod_reduce(modp, b_ada, b, 1 * D + k)); vS[k] = mod_reduce(modp, b_ada, b, 0 * D + k); }
            __syncthreads(); cur_b = b; }
#pragma unroll 1
        for (int i = 0; i < 8; ++i) { const size_t row = (size_t)ch * 64 + wave * 8 + i; row_norm_mod<HQ>(x_in + row * D, (unsigned char*)Hb + row * D * (HQ ? 1 : 2), rsh + row, vA, vS, lane); }
    }
    __syncthreads();
}
__device__ __forceinline__ void p6_phase(LAS unsigned char* lds, int tid, int blk, int G, const bf16* PROJ, float* kmean) {
    LAS float* red = (LAS float*)lds;
    for (int it = blk; it < 256; it += G) {
        const int b = it >> 6, kvh = (it >> 4) & 3, kb = it & 15;
        const int c8 = tid & 15, rg = tid >> 4;
        const bf16* src = PROJ + ((size_t)b * SEQ + kb * 256 + rg) * DIN + 4608 + kvh * 128 + c8 * 8;
        float s[8];
#pragma unroll
        for (int e = 0; e < 8; ++e) s[e] = 0.f;
#pragma unroll
        for (int i = 0; i < 8; ++i) { const v4u w = *(const v4u*)(src + (size_t)(32 * i) * DIN);
#pragma unroll
            for (int e = 0; e < 4; ++e) { s[2 * e] += bf_lo(w[e]); s[2 * e + 1] += bf_hi(w[e]); } }
#pragma unroll
        for (int e = 0; e < 8; ++e) red[rg * 128 + c8 * 8 + e] = s[e];
        __syncthreads();
        if (tid < 128) { float t = 0.f;
#pragma unroll
            for (int r = 0; r < 32; ++r) t += red[r * 128 + tid];
            kmean[(size_t)it * 128 + tid] = t * (1.0f / 256.f); }
        __syncthreads();
    }
}
template <int VAR = 0> __device__ __forceinline__ void p7_phase(LAS unsigned char* lds, int blk, int G, const bf16* PROJ, bf16* Ob, const float* kmean, const float* sinks) {
    for (int it = blk; it < 512 + 1024; it += G) {
        if (it < 512) { const int xcd = it & 7, k = it >> 3, bk = xcd + 8 * (k >> 5), xq = k & 31;
#pragma unroll 1
            for (int h = 0; h < 2; ++h) att::attn_unit<1, VAR>(lds, PROJ, Ob, kmean, sinks, bk >> 2, bk & 3, (h ? 63 - xq : xq) * 64); }
        else { const int u = it - 512, bk = u & 7, tqi = u >> 3;
            att::attn_unit<0, VAR>(lds, PROJ, Ob, kmean, sinks, bk >> 1, bk & 1, tqi * 32); }
    }
}

struct Args { const float* in[21]; float* out; unsigned char* ws; int ph_lo, ph_hi, pk, pad; };
static_assert(sizeof(Args) == 200, "Args has no padding bytes");

__global__ void __launch_bounds__(NWAVES * 64, 2) mk_fwd(Args args) {
    extern __shared__ __attribute__((aligned(16))) unsigned char lds_raw[];
    LAS unsigned char* lds = (LAS unsigned char*)lds_raw;
    volatile LAS unsigned* MISC = (volatile LAS unsigned*)(lds + LDSCTL_OFF);
    const int tid = threadIdx.x, lane = tid & 63, wave = __builtin_amdgcn_readfirstlane(tid >> 6);
    const int G = gridDim.x, blk = blockIdx.x;
    unsigned char* ws = args.ws;
    unsigned* ctl = (unsigned*)(ws + WS_CTL);
    const float* x_in = args.in[0]; const float* b_ada = args.in[3];
    const float* f1_pre = args.in[4]; const float* f1_post = args.in[5];
    const float* mx_pre = args.in[9]; const float* mx_post = args.in[10]; const float* sinks = args.in[12];
    const float* f2_pre = args.in[16]; const float* f2_post = args.in[17];
    float* out = args.out;
    float* modf = (float*)(ws + WS_MOD); float* kmean = (float*)(ws + WS_KMEAN); float* rsh = (float*)(ws + WS_RSH); float* rsa = (float*)(ws + WS_RSA);
    const float* P_c_in = args.in[1]; const float* P_w_ada = args.in[2]; const float* P_f1_wg = args.in[6]; const float* P_f1_wu = args.in[7]; const float* P_f1_wd = args.in[8]; const float* P_w_in = args.in[11]; const float* P_w_out = args.in[15];
    const float* P_norm_a = args.in[13]; const float* P_norm_b = args.in[14]; const float* P_f2_wg = args.in[18]; const float* P_f2_wu = args.in[19]; const float* P_f2_wd = args.in[20]; float* P_modp = (float*)(ws + WS_MODP);
    unsigned char* P_Wgu1 = ws + WS_WGU1; unsigned char* P_Wd1 = ws + WS_WD1; unsigned char* P_Win = ws + WS_WIN; unsigned char* P_Wout = ws + WS_WOUT; unsigned char* P_Wgu2 = ws + WS_WGU2; unsigned char* P_Wd2 = ws + WS_WD2; unsigned* P_cmax1 = ctl + CW_CMAX1; unsigned* P_cmax2 = ctl + CW_CMAX2; unsigned* P_cmaxo = ctl + CW_CMAXO;
    bf16* Hb = (bf16*)(ws + WS_H); bf16* ACT = (bf16*)(ws + WS_ACT); bf16* Yb = (bf16*)(ws + WS_Y); unsigned char* Y8 = ws + WS_Y; float* YSC = (float*)(ws + WS_Y + (size_t)M * D); bf16* PROJ = (bf16*)(ws + WS_PROJ); bf16* Ob = (bf16*)(ws + WS_O);
    signed char* ACT8 = (signed char*)(ws + WS_ACT8); bf16* XR = (bf16*)(ws + WS_XR); float* LSC = (float*)(ws + WS_ACT);

    for (int u = tid; u < (LDS_BYTES - LDSCTL_OFF) / 4; u += NWAVES * 64) ((LAS unsigned*)(lds + LDSCTL_OFF))[u] = 0u;
    __syncthreads();
    XcdBarrier bar; bar.bar = ctl + CW_BAR; bar.x = 0; bar.st = nullptr;
    if (N_LAUNCHES == 1) bar = xcd_barrier_post(ctl + CW_BAR, MISC + 8);
    const int lo = args.ph_lo, hi = args.ph_hi;
#define IN(k) (lo <= (k) && (k) < hi)
#define SEAM(k) do { if (IN(k) && IN((k) + 1)) xcd_barrier(bar); } while (0)

#define PH0() p0_phase(lds, wave, lane, blk, G, P0_ARGS)
#define PH1() p1_phase<F1Q ? 1 : 0>(lds, tid, wave, lane, blk, G, P0_ARGS, x_in, b_ada, f1_pre, modf, Hb, rsh)
#define GEMM_GU(Wt) do { pg8::Gemm g{Hb, (const bf16*)(Wt), M, 2 * FF, D}; pg8::StaticOrder S; S.init(M, 2 * FF, G, blk); pg8::EpiSwiGLU E{ACT, FF}; \
        pg8::gemm_phase<pg8::EpiSwiGLU, pg8::StaticOrder, true, true, 0>(lds, g, S, E); } while (0)
#define GEMM_GU_I8(Wt, CM, RM) do { pg8::Gemm g{Hb, (const bf16*)(Wt), M, 2 * FF, D / 2}; pg8::StaticOrder S; S.init(M, 2 * FF, G, blk); pg8::EpiSwiGLUQ E{ACT8, FF, LSC, NLS, rsh, CM, RM}; \
        pg8::gemm_phase<pg8::EpiSwiGLUQ, pg8::StaticOrder, true, true, 1>(lds, g, S, E); } while (0)
#define GEMM_BF(Aop, Wt, Nn, Kk, Out) do { pg8::Gemm g{Aop, (const bf16*)(Wt), M, Nn, Kk}; pg8::StaticOrder S; S.init(M, Nn, G, blk); pg8::EpiBf16P E{Out, Nn, 0u}; \
        pg8::gemm_phase<pg8::EpiBf16P, pg8::StaticOrder, true, true, 0>(lds, g, S, E); } while (0)
#define GEMM_DN_I8(Wt, CM) do { pg8::Gemm g{(const bf16*)ACT8, (const bf16*)(Wt), M, D, FF / 2}; pg8::StaticOrder S; S.init(M, D, G, blk); pg8::EpiQ8Y E{Y8, D, YSC, rsa, (CM) + CMAX_DN}; \
        pg8::gemm_phase<pg8::EpiQ8Y, pg8::StaticOrder, true, true, 1>(lds, g, S, E); } while (0)
#define ACTQ(RM) do { for (int row = blk * NWAVES + wave; row < M; row += G * NWAVES) row_actq(ACT8 + (size_t)row * FF, LSC + (size_t)row * NLS, (RM) + row, rsa + row, lane); } while (0)
#define RESID(NEXT, HQ, XS, OS, SRC, DST, I, RESW, GPOST, GPRE_NEXT, HQ2, HB2) do { \
        LAS float* vG = (LAS float*)lds; LAS float* vA = vG + D; LAS float* vS = vA + D; int cur_b = -1; \
        for (int ch = blk; ch < M / 64; ch += G) { const int b = ch / (SEQ / 64); \
            if (b != cur_b) { __syncthreads(); const float* mb = modf + (size_t)b * NMODV; \
                for (int k = tid; k < D; k += NWAVES * 64) { vG[k] = (RESW) * mb[(3 * (I) + 2) * D + k] * (GPOST)[k]; \
                    if (NEXT) { vA[k] = (GPRE_NEXT)[k] * (1.0f + mb[(3 * (I) + 4) * D + k]); vS[k] = mb[(3 * (I) + 3) * D + k]; } } \
                __syncthreads(); cur_b = b; } \
            _Pragma("unroll 1") for (int i = 0; i < 8; ++i) { const size_t row = (size_t)ch * 64 + wave * 8 + i; \
                row_resid<NEXT, HQ, XS, OS, HQ2>((const unsigned char*)(SRC) + row * D * ((XS) ? 2 : 4), Y8 + row * D, YSC + row * (D / 32), (unsigned char*)(DST) + row * D * ((OS) ? 2 : 4), (unsigned char*)Hb + row * D * ((HQ) ? 1 : 2), (unsigned char*)(HB2) + row * D * ((HQ2) == 1 ? 1 : 2), rsh + row, vG, vA, vS, lane); } } \
        __syncthreads(); } while (0)
#define PH2() do { if (F1Q) GEMM_GU_I8(P_Wgu1, P_cmax1, ctl + CW_ROWMAX1); else GEMM_GU(P_Wgu1); \
        { const int nsh_ = ((M / 256) * (2 * FF / 256)) % G; if (nsh_) pool_fill(lds, wave, lane, blk, G, nsh_, 0, FILLA, P0_ARGS); } } while (0)
#define PH3() ACTQ(ctl + CW_ROWMAX1)
#define PH4() do { if (F1Q) GEMM_DN_I8(P_Wd1, P_cmax1); else GEMM_BF(ACT, P_Wd1, D, FF, Yb); } while (0)
#define PH5() RESID(true, 0, 0, 1, x_in, XR, 0, 0.5f, f1_post, mx_pre, 1, ACT8)
#define GEMM_IN_I8() do { pg8::Gemm g{(const bf16*)ACT8, (const bf16*)(P_Win + WINA_OFF), M, NI8, D / 2}; pg8::StaticOrder S; S.init(M, NI8, G, blk); pg8::EpiBf16I8 E{PROJ, DIN, rsh, P_cmaxo + (CW_CMAXI - CW_CMAXO), I8MASK}; \
        pg8::gemm_phase<pg8::EpiBf16I8, pg8::StaticOrder, true, true, 1>(lds, g, S, E); } while (0)
#define GEMM_IN_BF() do { pg8::Gemm g{Hb, (const bf16*)P_Win, M, NBF, D}; pg8::StaticOrder S; S.init(M, NBF, G, blk); pg8::EpiBf16P E{PROJ, DIN, BFMASK}; \
        pg8::gemm_phase<pg8::EpiBf16P, pg8::StaticOrder, true, true, 0>(lds, g, S, E); } while (0)
#define PH6() do { GEMM_IN_BF(); GEMM_IN_I8();     \
        { const int nsa_ = ((M / 256) * (2 * FF / 256)) % G, nsh_ = ((M / 256) * (NI8 / 256)) % G; if (nsh_) pool_fill(lds, wave, lane, blk, G, nsh_, nsa_ ? FILLA * (G - nsa_) : 0, FILLB, P0_ARGS); } } while (0)
#define PH7() p6_phase(lds, tid, blk, G, PROJ, kmean)
#define PH8() p7_phase(lds, blk, G, PROJ, Ob, kmean, sinks)
#define PH9() do { for (int row = blk * NWAVES + wave; row < M; row += G * NWAVES) row_groupnorm<WOQ ? 1 : 0>(Ob + (size_t)row * D, (unsigned char*)Hb + (size_t)row * D * (WOQ ? 1 : 2), rsh + row, lane); } while (0)
#define GEMM_WO_I8() do { pg8::Gemm g{Hb, (const bf16*)P_Wout, M, D, D / 2}; pg8::StaticOrder S; S.init(M, D, G, blk); pg8::EpiQ8Y E{Y8, D, YSC, rsh, P_cmaxo}; \
        pg8::gemm_phase<pg8::EpiQ8Y, pg8::StaticOrder, true, true, 1>(lds, g, S, E); } while (0)
#define PH10() do { if (WOQ) GEMM_WO_I8(); else GEMM_BF(Hb, P_Wout, D, D, Yb); } while (0)
#define PH11() RESID(true, (F2Q ? 1 : 0), 1, 1, XR, XR, 1, 1.0f, mx_post, f2_pre, -1, Hb)
#define PH12() do { if (F2Q) GEMM_GU_I8(P_Wgu2, P_cmax2, ctl + CW_ROWMAX2); else GEMM_GU(P_Wgu2); \
        { const int nsa_ = ((M / 256) * (2 * FF / 256)) % G, nsb_ = ((M / 256) * (NI8 / 256)) % G; const int sa_ = nsa_ ? G - nsa_ : 0, sb_ = nsb_ ? G - nsb_ : 0; \
          if (nsa_ && FILLA * sa_ + FILLB * sb_ <= POOL_C0 && FILLC * sa_ <= I_W) pool_fill(lds, wave, lane, blk, G, nsa_, POOL_C0, FILLC, P0_ARGS); } } while (0)
#define PH13() ACTQ(ctl + CW_ROWMAX2)
#define PH14() do { if (F2Q) GEMM_DN_I8(P_Wd2, P_cmax2); else GEMM_BF(ACT, P_Wd2, D, FF, Yb); } while (0)
#define PH15() RESID(false, 0, 1, 0, XR, out, 2, 0.5f, f2_post, f2_post, -1, Hb)
#define RUN(k, EN, PH) do { if (EN) { if (IN(k)) { PH(); } SEAM(k); } } while (0)
    RUN(0, true, PH0);
    RUN(1, true, PH1);
    RUN(2, true, PH2);
    RUN(3, F1Q, PH3);
    RUN(4, true, PH4);
    RUN(5, true, PH5);
    RUN(6, true, PH6);
    RUN(7, true, PH7);
    RUN(8, true, PH8);
    RUN(9, true, PH9);
    RUN(10, true, PH10);
    RUN(11, true, PH11);
    RUN(12, true, PH12);
    RUN(13, F2Q, PH13);
    RUN(14, true, PH14);
    if (IN(15)) { PH15(); }
#if PROBE_DUP
    if (IN(16)) { pg8::Gemm g{Hb, (const bf16*)P_Wgu2, M, 2 * FF, args.pk}; pg8::StaticOrder S; S.init(M, 2 * FF, G, blk); pg8::EpiSwiGLUI8 E{ACT, FF, rsh, P_cmax2, ctl + CW_ROWMAX2};
        pg8::gemm_phase<pg8::EpiSwiGLUI8, pg8::StaticOrder, true, true, 1>(lds, g, S, E); }
    if (IN(17)) { pg8::Gemm g{Hb, (const bf16*)P_Wgu2, M, 2 * FF, args.pk}; pg8::StaticOrder S; S.init(M, 2 * FF, G, blk); pg8::EpiNull E{(float*)ACT};
        pg8::gemm_phase<pg8::EpiNull, pg8::StaticOrder, true, true, 1>(lds, g, S, E); }
#ifndef PROBE_E
#define PROBE_E 0
#endif
    if (IN(18)) { typedef pg8::EpiSwiGLUI8T<(PROBE_E & 1) != 0, (PROBE_E & 2) != 0> EP; pg8::Gemm g{Hb, (const bf16*)P_Wgu2, M, 2 * FF, args.pk}; pg8::StaticOrder S; S.init(M, 2 * FF, G, blk); EP E{ACT, FF, rsh, P_cmax2, ctl + CW_ROWMAX2};
        pg8::gemm_phase<EP, pg8::StaticOrder, true, true, 1>(lds, g, S, E); }
    if (IN(19)) p7_phase<PROBE_E>(lds, blk, G, PROJ, Ob, kmean, sinks);
#endif
#undef IN
#undef SEAM
}

extern "C" void kernel_launch(void* const* d_in, const int* in_sizes, int n_in, void* d_out, int out_size, void* d_ws, size_t ws_size, hipStream_t stream) {
    static int grid = 0;
    if (grid == 0) {
        if (n_in != 21 || in_sizes[0] != M * D || out_size != M * D || ws_size < WS_END) { fprintf(stderr, "kernel_launch: unexpected shapes (n_in %d, in0 %d, out %d, ws %zu; need ws >= %zu); nothing launched\n", n_in, n_in > 0 ? in_sizes[0] : -1, out_size, ws_size, (size_t)WS_END); grid = -1; return; }
        int dev = 0, cus = 0, per_cu = 0;
        if (hipGetDevice(&dev) != hipSuccess || hipDeviceGetAttribute(&cus, hipDeviceAttributeMultiprocessorCount, dev) != hipSuccess) { fprintf(stderr, "kernel_launch: device query failed\n"); grid = -1; return; }
        if (hipFuncSetAttribute((const void*)mk_fwd, hipFuncAttributeMaxDynamicSharedMemorySize, LDS_BYTES) != hipSuccess) { fprintf(stderr, "kernel_launch: hipFuncSetAttribute failed\n"); grid = -1; return; }
        if (hipOccupancyMaxActiveBlocksPerMultiprocessor(&per_cu, (const void*)mk_fwd, NWAVES * 64, LDS_BYTES) != hipSuccess || per_cu < 1) { fprintf(stderr, "kernel_launch: occupancy query reports %d workgroups per CU\n", per_cu); }
        (void)hipGetLastError();
        grid = cus;
    }
    if (grid < 0) return;
    if (hipMemsetAsync((char*)d_ws + WS_CTL, 0, CTL_ZERO_BYTES, stream) != hipSuccess) { fprintf(stderr, "kernel_launch: hipMemsetAsync failed\n"); return; }
    Args a{};
    for (int i = 0; i < 21; ++i) a.in[i] = (const float*)d_in[i];
    a.out = (float*)d_out; a.ws = (unsigned char*)d_ws; a.pk = PROBE_PK; a.pad = 0;
    if (N_LAUNCHES == 1) { a.ph_lo = 0; a.ph_hi = N_PHASES; hipLaunchKernelGGL(mk_fwd, dim3(grid), dim3(NWAVES * 64), LDS_BYTES, stream, a); }
    else { for (int p = 0; p < N_PHASES + 4; ++p) { if ((p == 3 && !F1Q) || (p == 13 && !F2Q)) continue; a.ph_lo = p; a.ph_hi = p + 1; const int nrep = (p < N_PHASES ? 1 : 0) + (((PROBE_DUP) >> p) & 1);
            for (int r = 0; r < nrep; ++r) hipLaunchKernelGGL(mk_fwd, dim3(grid), dim3(NWAVES * 64), LDS_BYTES, stream, a); } }
    const hipError_t le = hipPeekAtLastError();
    if (le != hipSuccess) fprintf(stderr, "kernel_launch: launch failed: %s\n", hipGetErrorName(le));
}
```
